# Optimizing an MI355X kernel written in HIP

```python
import jax
import jax.numpy as jnp
from jax import lax
import numpy as np

D_MODEL = 1024
BATCH = 8
SEQ = 2048
DEPTH = 4

N_EVEN = (DEPTH + 1) // 2
N_ODD = DEPTH // 2
POOL_WINDOWS = (2, 4, 8, 16)
POOL_GROUPS = 4
POOL_CH = D_MODEL // 8
POOL_WIDTH = POOL_GROUPS * POOL_CH
ATTN_HEADS = 8
HEAD_DIM = D_MODEL // 16
ATTN_WIDTH = ATTN_HEADS * HEAD_DIM
DILATED_PATTERNS = ((128, 1), (512, 4), (2048, 16))
AB_IN = POOL_WIDTH + 3 * ATTN_WIDTH
AB_OUT = POOL_WIDTH + ATTN_WIDTH
GM_CHUNK = 128
GM_GROUPS = 8
GM_WIDTH = D_MODEL
GM_CH = GM_WIDTH // GM_GROUPS
N_GROUPS = 8
EXPERTS_PER_GROUP = 8
N_EXPERTS = N_GROUPS * EXPERTS_PER_GROUP
TOP_K = 2
D_EXPERT = D_MODEL // 2
ROW_BLOCK = 128
EPS = 1e-6

kernel_name = "hybrid_pool_dilated_gmlp_hmoe"


def rms_norm(x, g):
    xf = x.astype(jnp.float32)
    y = xf * lax.rsqrt(jnp.mean(xf * xf, axis=-1, keepdims=True) + EPS) * g.astype(jnp.float32)
    return y.astype(x.dtype)


def layer_norm(x, g):
    xf = x.astype(jnp.float32)
    xc = xf - jnp.mean(xf, axis=-1, keepdims=True)
    return xc * lax.rsqrt(jnp.mean(xc * xc, axis=-1, keepdims=True) + EPS) * g.astype(jnp.float32)


def causal_mean(z, window):
    S = z.shape[1]
    c = jnp.pad(jnp.cumsum(z, axis=1), ((0, 0), (1, 0), (0, 0)))
    hi = c[:, 1:]
    lo = jnp.pad(c, ((0, 0), (window - 1, 0), (0, 0)))[:, :S]
    count = jnp.minimum(jnp.arange(S) + 1, window).astype(jnp.float32)[None, :, None]
    return (hi - lo) / count


def dilated_branch(q, k, v, window, dilation):
    B, S, H, E = q.shape
    W = window // dilation
    L = S // dilation
    nb = -(-L // W)
    Lp = nb * W

    def to_blocks(t):
        t = t.reshape(B, L, dilation, H, E).transpose(0, 2, 1, 3, 4)
        t = jnp.pad(t, ((0, 0), (0, 0), (0, Lp - L), (0, 0), (0, 0)))
        return t.reshape(B, dilation, nb, W, H, E)

    def with_prev(t):
        prev = jnp.pad(t, ((0, 0), (0, 0), (1, 0), (0, 0), (0, 0), (0, 0)))[:, :, :nb]
        return jnp.concatenate([prev, t], axis=3)

    qb = to_blocks(q)
    kk = with_prev(to_blocks(k))
    vv = with_prev(to_blocks(v))
    s = jnp.einsum('brnqhe,brnkhe->brnhqk', qb, kk) * (HEAD_DIM ** -0.5)
    qi = jnp.arange(W)[:, None]
    kj = jnp.arange(2 * W)[None, :]
    dist = qi + W - kj
    kpos = jnp.arange(nb)[:, None, None] * W + kj[None] - W
    mask = (dist >= 0)[None] & (dist <= W)[None] & (kpos >= 0)
    s = jnp.where(mask[None, None, :, None], s, -jnp.inf)
    m = jnp.max(s, axis=-1, keepdims=True)
    p = jnp.exp(s - m)
    den = jnp.sum(p, axis=-1)
    o = jnp.einsum('brnhqk,brnkhe->brnqhe', p, vv) / jnp.swapaxes(den, 3, 4)[..., None]
    lse = jnp.swapaxes(m[..., 0] + jnp.log(den), 3, 4)

    def from_blocks(t):
        rest = t.shape[4:]
        t = t.reshape((B, dilation, Lp) + rest)[:, :, :L]
        t = jnp.moveaxis(t, 2, 1)
        return t.reshape((B, S) + rest)

    return from_blocks(o), from_blocks(lse)


def dilated_attention(q, k, v):
    outs, lses = [], []
    for window, dilation in DILATED_PATTERNS:
        o, l = dilated_branch(q, k, v, window, dilation)
        outs.append(o)
        lses.append(l)
    wts = jax.nn.softmax(jnp.stack(lses, axis=0), axis=0)
    return jnp.sum(wts[..., None] * jnp.stack(outs, axis=0), axis=0)


def pool_attn_mixer(h, w_in, w_out, pool_w, pool_scale):
    B, S, _ = h.shape
    z = h @ w_in
    zp = z[..., :POOL_WIDTH]
    q = z[..., POOL_WIDTH:POOL_WIDTH + ATTN_WIDTH]
    k = z[..., POOL_WIDTH + ATTN_WIDTH:POOL_WIDTH + 2 * ATTN_WIDTH]
    v = z[..., POOL_WIDTH + 2 * ATTN_WIDTH:]
    zpf = zp.astype(jnp.float32).reshape(B, S, POOL_GROUPS, POOL_CH)
    pooled = jnp.stack([causal_mean(zpf[:, :, g], w) for g, w in enumerate(POOL_WINDOWS)], axis=2) - zpf
    a = jnp.einsum('bsgc,gcd->bsgd', pooled, pool_w).reshape(B, S, POOL_WIDTH) * pool_scale
    to_heads = lambda t: t.astype(jnp.float32).reshape(B, S, ATTN_HEADS, HEAD_DIM)
    o = dilated_attention(to_heads(q), to_heads(k), to_heads(v)).reshape(B, S, ATTN_WIDTH)
    y = jnp.concatenate([a, o], axis=-1).astype(h.dtype)
    return y @ w_out


def gmlp_mixer(h, w_in, norm_g, ws, bs, w_out):
    B, S, _ = h.shape
    z = jax.nn.gelu(h @ w_in)
    u = z[..., :GM_WIDTH].astype(jnp.float32)
    v = layer_norm(z[..., GM_WIDTH:], norm_g)
    vc = v.reshape(B, S // GM_CHUNK, GM_CHUNK, GM_GROUPS, GM_CH)
    tril = jnp.tril(jnp.ones((GM_CHUNK, GM_CHUNK), jnp.float32))
    ws_c = ws.astype(jnp.float32) * tril[None]
    sv = jnp.einsum('gij,bnjgc->bnigc', ws_c, vc) + bs.astype(jnp.float32).T[None, None, :, :, None]
    y = (u * sv.reshape(B, S, GM_WIDTH)).astype(h.dtype)
    return y @ w_out


def hierarchical_moe(h, group_w, group_b, exp_w, exp_b, w_gate, w_up, w_down):
    N, D = h.shape
    g_prob = jax.nn.softmax((h @ group_w).astype(jnp.float32) + group_b, axis=-1)
    g_top_p, g_idx = lax.top_k(g_prob, 1)
    e_logits = ((h @ exp_w).astype(jnp.float32) + exp_b).reshape(N, N_GROUPS, EXPERTS_PER_GROUP)
    e_logits = jnp.take_along_axis(e_logits, g_idx[:, :, None], axis=1)[:, 0]
    e_top, e_idx = lax.top_k(e_logits, TOP_K)
    gate = g_top_p * jax.nn.softmax(e_top, axis=-1)
    expert = g_idx * EXPERTS_PER_GROUP + e_idx

    NK = N * TOP_K
    flat_e = expert.reshape(-1)
    flat_tok = jnp.repeat(jnp.arange(N, dtype=jnp.int32), TOP_K)
    flat_gate = gate.reshape(-1)
    order = jnp.argsort(flat_e)
    se = flat_e[order]
    counts = jnp.bincount(flat_e, length=N_EXPERTS)
    starts = jnp.cumsum(counts) - counts
    pcounts = (counts + ROW_BLOCK - 1) // ROW_BLOCK * ROW_BLOCK
    pends = jnp.cumsum(pcounts)
    pstarts = pends - pcounts
    dest = pstarts[se] + jnp.arange(NK) - starts[se]
    n_rows = (NK + N_EXPERTS * (ROW_BLOCK - 1) + ROW_BLOCK - 1) // ROW_BLOCK * ROW_BLOCK
    n_blk = n_rows // ROW_BLOCK
    row_tok = jnp.full((n_rows,), N, jnp.int32).at[dest].set(flat_tok[order])
    row_gate = jnp.zeros((n_rows,), jnp.float32).at[dest].set(flat_gate[order])
    blk_expert = jnp.minimum(jnp.searchsorted(pends, jnp.arange(n_blk) * ROW_BLOCK, side='right'),
                             N_EXPERTS - 1)
    h_pad = jnp.concatenate([h, jnp.zeros((1, D), h.dtype)], axis=0)
    xb = h_pad[row_tok].reshape(n_blk, ROW_BLOCK, D)

    def expert_block(args):
        xblk, e = args
        a = xblk @ w_gate[e]
        b = xblk @ w_up[e]
        return (jax.nn.silu(a) * b) @ w_down[e]

    yb = lax.map(expert_block, (xb, blk_expert)).reshape(n_rows, D)
    out = jnp.zeros((N + 1, D), jnp.float32).at[row_tok].add(yb.astype(jnp.float32) * row_gate[:, None])
    return out[:N].astype(h.dtype)


def setup_inputs(seed: int = 0) -> dict:
    key = jax.random.key(seed)
    ks = jax.random.split(key, 20)
    f32 = jnp.float32
    D = D_MODEL

    def nrm(k, shape, scale):
        return jax.random.normal(k, shape, f32) * scale

    return {
        "x": nrm(ks[0], (BATCH, SEQ, D), 1.0),
        "norm_mix": 1.0 + nrm(ks[1], (DEPTH, D), 0.05),
        "norm_ffn": 1.0 + nrm(ks[2], (DEPTH, D), 0.05),
        "norm_final": 1.0 + nrm(ks[3], (D,), 0.05),
        "ab_w_in": nrm(ks[4], (N_EVEN, D, AB_IN), D ** -0.5),
        "ab_w_out": nrm(ks[5], (N_EVEN, AB_OUT, D), AB_OUT ** -0.5),
        "pool_w": nrm(ks[6], (N_EVEN, POOL_GROUPS, POOL_CH, POOL_CH), POOL_CH ** -0.5),
        "pool_scale": 1.0 + nrm(ks[7], (N_EVEN, POOL_WIDTH), 0.1),
        "gm_w_in": nrm(ks[8], (N_ODD, D, 2 * GM_WIDTH), D ** -0.5),
        "gm_norm": 1.0 + nrm(ks[9], (N_ODD, GM_WIDTH), 0.05),
        "gm_ws": nrm(ks[10], (N_ODD, GM_GROUPS, GM_CHUNK, GM_CHUNK), GM_CHUNK ** -0.5),
        "gm_bs": 1.0 + nrm(ks[11], (N_ODD, GM_GROUPS, GM_CHUNK), 0.1),
        "gm_w_out": nrm(ks[12], (N_ODD, GM_WIDTH, D), GM_WIDTH ** -0.5),
        "router_group_w": nrm(ks[13], (DEPTH, D, N_GROUPS), D ** -0.5),
        "router_group_b": nrm(ks[14], (DEPTH, N_GROUPS), 0.01),
        "router_expert_w": nrm(ks[15], (DEPTH, D, N_EXPERTS), D ** -0.5),
        "router_expert_b": nrm(ks[16], (DEPTH, N_EXPERTS), 0.01),
        "moe_w_gate": nrm(ks[17], (DEPTH, N_EXPERTS, D, D_EXPERT), D ** -0.5),
        "moe_w_up": nrm(ks[18], (DEPTH, N_EXPERTS, D, D_EXPERT), D ** -0.5),
        "moe_w_down": nrm(ks[19], (DEPTH, N_EXPERTS, D_EXPERT, D), D_EXPERT ** -0.5),
    }


def reference(x, norm_mix, norm_ffn, norm_final, ab_w_in, ab_w_out, pool_w, pool_scale,
              gm_w_in, gm_norm, gm_ws, gm_bs, gm_w_out, router_group_w, router_group_b,
              router_expert_w, router_expert_b, moe_w_gate, moe_w_up, moe_w_down):
    B, S, D = x.shape
    for layer in range(DEPTH):
        i = layer // 2
        h = rms_norm(x, norm_mix[layer])
        if layer % 2 == 0:
            x = x + pool_attn_mixer(h, ab_w_in[i], ab_w_out[i], pool_w[i], pool_scale[i])
        else:
            x = x + gmlp_mixer(h, gm_w_in[i], gm_norm[i], gm_ws[i], gm_bs[i], gm_w_out[i])
        h = rms_norm(x, norm_ffn[layer]).reshape(B * S, D)
        x = x + hierarchical_moe(h, router_group_w[layer], router_group_b[layer],
                                 router_expert_w[layer], router_expert_b[layer],
                                 moe_w_gate[layer], moe_w_up[layer], moe_w_down[layer]).reshape(B, S, D)
    return rms_norm(x, norm_final)
```

```cpp
#include <hip/hip_runtime.h>
#include <cstdio>
#include <cstdint>

#ifndef MK_ONE_LAUNCH
#define MK_ONE_LAUNCH 1
#endif

#define LAS __attribute__((address_space(3)))
#define GAS __attribute__((address_space(1)))
typedef unsigned short bf16_t;
typedef short bf16x8 __attribute__((ext_vector_type(8)));
typedef float f32x4 __attribute__((ext_vector_type(4)));
typedef float f32x2 __attribute__((ext_vector_type(2)));
typedef unsigned u32x4 __attribute__((ext_vector_type(4)));
typedef unsigned u32x2 __attribute__((ext_vector_type(2)));
typedef int i32x4 __attribute__((ext_vector_type(4)));
typedef int i32x2 __attribute__((ext_vector_type(2)));

constexpr int NT = 16384, DM = 1024, SEQ = 2048, NL = 4, NE = 64, DE = 512;
constexpr int NWAVES = 8, NTHR = 512;
constexpr float EPS = 1e-6f;
constexpr int ZP = 2048 + 64;
constexpr int ZERO_ROW = NT;
constexpr int NR_ALLOC = 42496;

constexpr size_t MiB = 1u << 20;
constexpr size_t WS_CTL = 0, CTL_ZERO_BYTES = 1 * MiB;
constexpr size_t WS_WSB = 1 * MiB;
constexpr size_t WS_PWT = 1 * MiB + 512 * 1024;
constexpr size_t WS_WIN = 2 * MiB;
constexpr size_t WS_WOUT = 18 * MiB;
constexpr size_t WS_Z = 292 * MiB;
constexpr size_t WS_YM = 123 * MiB;
constexpr size_t WS_VSTAT = 155 * MiB;
constexpr size_t WS_LIST = 400 * MiB;
constexpr size_t WS_TOKINFO = 165 * MiB;
constexpr size_t WS_RSTD = 165 * MiB + 512 * 1024;
constexpr size_t WS_HMOE = 166 * MiB;
constexpr size_t WS_YMOE = 208 * MiB;
constexpr size_t WS_XB = 420 * MiB;
constexpr size_t WS_X16 = 1092 * MiB;
constexpr size_t WS_WRT = 1124 * MiB;
constexpr size_t WS_END = 1126 * MiB;
constexpr int CW_TMO = 0, CW_BAR = 4096, CW_CNT = 8192  , CW_DBG = 40960, CW_BLK = 65536  ;

constexpr int RING_BYTES = 147456;
constexpr int MISC_OFF = RING_BYTES;
constexpr int LDS_BYTES = 161792;
constexpr int MO_BAR = 0;
constexpr int MO_CNT = 64;
constexpr int MO_SEG = MO_CNT + 256;
constexpr int MO_FST = MO_SEG + 272;
constexpr int MO_HST = MO_FST + 272;
constexpr int MAXU = 4;
constexpr int MO_TAB = MO_HST + 272;
constexpr int MO_NMY = MO_TAB + MAXU * 32;
constexpr int MO_TOKS = 2048;
constexpr int MO_GATES = 2048 + 4096;
static_assert(MO_NMY + 4 * MAXU <= MO_TOKS, "misc map");
constexpr int MO_RSTD = MO_GATES + 4096;
static_assert(MISC_OFF + MO_RSTD + MAXU * 1024 <= LDS_BYTES, "misc map 2");

__device__ __forceinline__ unsigned cvt_pk_bf16(float lo, float hi) { unsigned r; asm volatile("v_cvt_pk_bf16_f32 %0, %1, %2" : "=v"(r) : "v"(lo), "v"(hi)); return r; }
__device__ __forceinline__ float bf_lo(unsigned u) { return __builtin_bit_cast(float, u << 16); }
__device__ __forceinline__ float bf_hi(unsigned u) { return __builtin_bit_cast(float, u & 0xffff0000u); }
__device__ __forceinline__ float wave_sum(float v) {
#pragma unroll
    for (int o = 1; o < 64; o <<= 1) v += __shfl_xor(v, o);
    return v;
}
__device__ __forceinline__ float wave_max(float v) {
#pragma unroll
    for (int o = 1; o < 64; o <<= 1) v = fmaxf(v, __shfl_xor(v, o));
    return v;
}
__device__ __forceinline__ float gelu_tanh(float x) {
    const float u = 0.7978845608028654f * (x + 0.044715f * x * x * x);
    const float e = __builtin_amdgcn_exp2f(-2.0f * 1.4426950408889634f * u);
    return x * __builtin_amdgcn_rcpf(1.0f + e);
}
__device__ __forceinline__ float silu_f(float x) {
    const float e = __builtin_amdgcn_exp2f(-1.4426950408889634f * x);
    return x * __builtin_amdgcn_rcpf(1.0f + e);
}
__device__ __forceinline__ int opaque_tid() { int t = (int)threadIdx.x; asm volatile("" : "+v"(t)); return t; }
#define LDS_WAIT() asm volatile("s_waitcnt lgkmcnt(0)" ::: "memory")
#define VM_WAIT() asm volatile("s_waitcnt vmcnt(0)" ::: "memory")

#define XB_TMO      128
#define XB_XCNT(j)  (256  + 64 * (j))
#define XB_XSUB(j)  (1280 + 64 * (j))
#define XB_XGEN(j)  (2304 + 64 * (j))
#define XB_TOP      3328
#define XB_TOPGEN   3392
#define XCD_BAR_WORDS 3456
#define XB_SPIN_CAP (1u << 20)

__device__ __forceinline__ unsigned xb_ld(unsigned* p)              { return __hip_atomic_load(p, __ATOMIC_RELAXED, __HIP_MEMORY_SCOPE_AGENT); }
__device__ __forceinline__ unsigned xb_add(unsigned* p, unsigned v) { return __hip_atomic_fetch_add(p, v, __ATOMIC_RELAXED, __HIP_MEMORY_SCOPE_AGENT); }
__device__ __forceinline__ unsigned xb_xcc_id() { return (unsigned)__builtin_amdgcn_s_getreg((3 << 11) | 20) & 0xFu; }
#define XB_SPIN(cond, bar) do { unsigned _sp = 0; while (cond) { __builtin_amdgcn_s_sleep(1); \
    if ((++_sp & 255u) == 0u) { if (xb_ld(&(bar)[XB_TMO])) break; if (_sp > XB_SPIN_CAP) { atomicAdd(&(bar)[XB_TMO], 1u); break; } } } } while (0)

struct XcdBarrier { unsigned* bar; unsigned x; volatile LAS unsigned* st; };

__device__ __forceinline__ XcdBarrier xcd_barrier_post(unsigned* bar, volatile LAS unsigned* st) {
    XcdBarrier b; b.bar = bar; b.x = xb_xcc_id(); b.st = st;
    if (threadIdx.x == 0) (void)xb_add(&bar[XB_XCNT(b.x)], 1u);
    return b;
}
__device__ __forceinline__ void xcd_barrier_complete(unsigned* bar, unsigned x, unsigned& nloc, unsigned& nx) {
    const unsigned G = gridDim.x * gridDim.y * gridDim.z;
    unsigned sum, cnt, mine, sp = 0u;
    for (;;) {
        sum = 0u; cnt = 0u; mine = 0u;
#pragma unroll
        for (unsigned j = 0; j < 16; ++j) { const unsigned c = xb_ld(&bar[XB_XCNT(j)]); sum += c; cnt += (c > 0u) ? 1u : 0u; mine = (j == x) ? c : mine; }
        if (sum == G) break;
        __builtin_amdgcn_s_sleep(1);
        if ((++sp & 255u) == 0u) { if (xb_ld(&bar[XB_TMO])) break; if (sp > XB_SPIN_CAP) { atomicAdd(&bar[XB_TMO], 1u); break; } }
    }
    nloc = mine > 0u ? mine : 1u; nx = cnt > 0u ? cnt : 1u;
}
__device__ __forceinline__ void xcd_barrier(const XcdBarrier& b) {
    asm volatile("s_waitcnt vmcnt(0)" ::: "memory");
    __syncthreads();
    if (threadIdx.x == 0) {
        unsigned* bar = b.bar;
        __builtin_amdgcn_s_waitcnt(0);
        unsigned nloc = b.st[0], nx = b.st[1];
        if (nloc == 0u) { xcd_barrier_complete(bar, b.x, nloc, nx); b.st[0] = nloc; b.st[1] = nx; }
        const unsigned old = xb_add(&bar[XB_XSUB(b.x)], 1u);
        const unsigned gen = old / nloc;
        if (old + 1u == (gen + 1u) * nloc) {
            __builtin_amdgcn_fence(__ATOMIC_RELEASE, "agent");
            asm volatile("s_waitcnt vmcnt(0)" ::: "memory");
            const unsigned og = xb_add(&bar[XB_TOP], 1u);
            const unsigned tg = og / nx;
            if (og + 1u == (tg + 1u) * nx) xb_add(&bar[XB_TOPGEN], 1u);
            else XB_SPIN(xb_ld(&bar[XB_TOPGEN]) == tg, bar);
            __builtin_amdgcn_fence(__ATOMIC_ACQUIRE, "agent");
            xb_add(&bar[XB_XGEN(b.x)], 1u);
            asm volatile("s_waitcnt vmcnt(0)" ::: "memory");
        } else {
            XB_SPIN(xb_ld(&bar[XB_XGEN(b.x)]) == gen, bar);
            __builtin_amdgcn_fence(__ATOMIC_ACQUIRE, "agent");
            asm volatile("s_waitcnt vmcnt(0)" ::: "memory");
        }
    }
    __syncthreads();
}

namespace pg8 {
constexpr int BM = 256, BK = 64, HALF = 128, HTB = HALF * BK * 2, STAGE_BYTES = 8 * HTB, NXCD = 8, WGM = 8;
__host__ __device__ __forceinline__ int lds_byte(int r, int c) { const int st = (r >> 4) * 2 + (c >> 5), rr = r & 15, cc = c & 31, ob = rr * 64 + cc * 2; return st * 1024 + (ob ^ (((ob >> 9) & 1) << 5)); }
__host__ __device__ __forceinline__ void stage_rc(int b, int& R, int& C) { const int st = b / 1024, sb = b % 1024, swz = sb ^ (((sb >> 9) & 1) << 5); R = (st >> 1) * 16 + swz / 64; C = (st & 1) * 32 + (swz % 64) / 2; }
__host__ __device__ __forceinline__ int perm32(int rho) { const int n = rho >> 4, i = rho & 15; return 8 * (i >> 2) + 4 * n + (i & 3); }

struct Unit { const char* A; const char* B; int rowbase; int pn; int nvalid; int slot; };

struct PlainSched {
    static constexpr bool ALWAYS_FULL = true;
    const char* A; const char* Bt; int K; int nM, nN, nwg, G, c;
    __device__ __forceinline__ void init(const void* A_, const void* Bt_, int M, int N, int K_, int G_, int c_) { A = (const char*)A_; Bt = (const char*)Bt_; K = K_; nM = M / BM; nN = N / BM; nwg = nM * nN; G = G_; c = c_; }
    __device__ __forceinline__ bool next(int i, Unit& u) const {
        const long L = (long)i * G + c; if (L >= nwg) return false;
        int wgid = (int)L; { const int q = nwg / NXCD, r = nwg % NXCD, xcd = wgid % NXCD, off = wgid / NXCD; wgid = (xcd < r ? xcd * (q + 1) : r * (q + 1) + (xcd - r) * q) + off; }
        const int nig = WGM * nN, gid = wgid / nig, fm = gid * WGM, gsz = (nM - fm) < WGM ? (nM - fm) : WGM;
        const int pm = fm + ((wgid % nig) % gsz), pn = (wgid % nig) / gsz;
        u.A = A + (size_t)pm * BM * K * 2; u.B = Bt + (size_t)pn * BM * K * 2; u.rowbase = pm * BM; u.pn = pn; u.nvalid = 256; u.slot = 0; return true;
    }
    __device__ __forceinline__ void aoff(const Unit& u, const int (&R)[2], const int (&C)[2], unsigned (&vo)[2][2]) const {
#pragma unroll
        for (int h = 0; h < 2; ++h)
#pragma unroll
            for (int i = 0; i < 2; ++i) vo[h][i] = (unsigned)(((h * HALF + R[i]) * K + C[i]) * 2);
    }
};

template <class Epi, class Sched, bool ALIGN_EPI>
__device__ __forceinline__ void gemm_phase(LAS unsigned char* lds, const int K, const Sched& S, const Epi& E) {
    const int tid = opaque_tid(), wid = __builtin_amdgcn_readfirstlane(tid >> 6), lane = tid & 63, wr = wid >> 2, wc = wid & 3, fr = lane & 15, fq = lane >> 4;
    const int nt = K / BK;
    int Rr[2], Cc[2]; unsigned voffB[2];
#pragma unroll
    for (int i = 0; i < 2; ++i) { int R, C; stage_rc(tid * 16 + i * 8192, R, C); const int Rb = Epi::PERM ? ((R & ~31) + perm32(R & 31)) : R;
        Rr[i] = R; Cc[i] = C; voffB[i] = (unsigned)(Rb * K + C) * 2u; }
    const size_t kstep = (size_t)(BK * 2);
    const size_t hstepB = (size_t)HALF * K * 2;
    const unsigned ldsw = (unsigned)wid * 1024u;
    const int aoff = lds_byte(wr * 64 + fr, fq * 8), boff = lds_byte(wc * 32 + fr, fq * 8);
#define PG8_SA(b, h) (((b) * 2 + (h)) * HTB)
#define PG8_SB(b, h) ((4 + (b) * 2 + (h)) * HTB)
#define PG8_STAGE(bufoff, gbase, voff) do { _Pragma("unroll") for (int _i = 0; _i < 2; ++_i) \
        __builtin_amdgcn_global_load_lds((const unsigned*)((const char*)(gbase) + (voff)[_i]), (LAS unsigned*)(lds + (bufoff) + ldsw + _i * 8192), 16, 0, 0); } while (0)
#define PG8_LDA(dst, b, h) do { _Pragma("unroll") for (int m = 0; m < 4; ++m) _Pragma("unroll") for (int k = 0; k < 2; ++k) dst[m][k] = *(const LAS bf16x8*)(lds + PG8_SA(b, h) + aoff + m * 2048 + k * 1024); } while (0)
#define PG8_LDB(dst, b, h) do { _Pragma("unroll") for (int n = 0; n < 2; ++n) _Pragma("unroll") for (int k = 0; k < 2; ++k) dst[n][k] = *(const LAS bf16x8*)(lds + PG8_SB(b, h) + boff + n * 2048 + k * 1024); } while (0)
#define PG8_MMA(ai, bj, At, Bt) do { __builtin_amdgcn_s_setprio(1); _Pragma("unroll") for (int m = 0; m < 4; ++m) _Pragma("unroll") for (int n = 0; n < 2; ++n) _Pragma("unroll") for (int k = 0; k < 2; ++k) \
        acc[ai][bj][m][n] = __builtin_amdgcn_mfma_f32_16x16x32_bf16(Bt[n][k], At[m][k], acc[ai][bj][m][n], 0, 0, 0); __builtin_amdgcn_s_setprio(0); } while (0)
#define PG8_WAIT_V(n) asm volatile("s_waitcnt vmcnt(" #n ")" ::: "memory")
#define PG8_WAIT_L(n) asm volatile("s_waitcnt lgkmcnt(" #n ")" ::: "memory")
#define PG8_BAR __builtin_amdgcn_s_barrier()
#define PG8_SCHED __builtin_amdgcn_sched_barrier(0)
    Unit cur, nxt; int ui = 0;
    if (!S.next(0, cur)) return;
    f32x4 acc[2][2][4][2];
#pragma unroll
    for (int a = 0; a < 2; ++a)
#pragma unroll
        for (int b = 0; b < 2; ++b)
#pragma unroll
            for (int m = 0; m < 4; ++m)
#pragma unroll
                for (int n = 0; n < 2; ++n) acc[a][b][m][n] = (f32x4){0.f, 0.f, 0.f, 0.f};
    bf16x8 At[4][2], B0[2][2], B1[2][2];
    unsigned vo[2][2];
    S.aoff(cur, Rr, Cc, vo);
    {
        const char* cA = cur.A; const char* cB = cur.B;
        PG8_STAGE(PG8_SB(0, 0), cB, voffB); PG8_STAGE(PG8_SB(0, 1), cB + hstepB, voffB); PG8_STAGE(PG8_SA(0, 0), cA, vo[0]); PG8_STAGE(PG8_SA(0, 1), cA, vo[1]);
        if (wr == 1) PG8_BAR;
        PG8_WAIT_V(2); PG8_BAR;
        PG8_STAGE(PG8_SB(1, 0), cB + kstep, voffB); PG8_STAGE(PG8_SA(1, 0), cA + kstep, vo[0]); PG8_STAGE(PG8_SB(1, 1), cB + hstepB + kstep, voffB);
        PG8_WAIT_V(6); PG8_BAR;
    }
    for (;;) {
        const bool has_next = S.next(ui + 1, nxt);
        const char* cA = cur.A; const char* cB = cur.B;
        const char* nA = has_next ? nxt.A : cA; const char* nB = has_next ? nxt.B : cB;
        const bool full = Sched::ALWAYS_FULL ? true : (cur.nvalid > 128);
        for (int t = 0; t < nt; t += 2) {
            const bool last = (t == nt - 2);
            const char* a1 = cA + (size_t)(t + 1) * kstep;
            const char* a2 = last ? nA : cA + (size_t)(t + 2) * kstep; const char* b2 = last ? nB : cB + (size_t)(t + 2) * kstep;
            const char* a3 = a2 + kstep; const char* b3 = b2 + kstep;
            PG8_LDB(B0, 0, 0); PG8_LDB(B1, 0, 1); PG8_SCHED; PG8_LDA(At, 0, 0); PG8_STAGE(PG8_SA(1, 1), a1, vo[1]);
            if (last && has_next) S.aoff(nxt, Rr, Cc, vo);
            PG8_WAIT_V(8); PG8_WAIT_L(0); PG8_BAR; PG8_MMA(0, 0, At, B0); PG8_MMA(0, 1, At, B1); PG8_BAR; PG8_SCHED;
            PG8_LDA(At, 0, 1); PG8_STAGE(PG8_SB(0, 0), b2, voffB); PG8_STAGE(PG8_SB(0, 1), b2 + hstepB, voffB); PG8_STAGE(PG8_SA(0, 0), a2, vo[0]);
            PG8_WAIT_V(8); PG8_WAIT_L(0); PG8_BAR; if (full) { PG8_MMA(1, 0, At, B0); PG8_MMA(1, 1, At, B1); } PG8_BAR; PG8_SCHED;
            PG8_LDB(B0, 1, 0); PG8_LDB(B1, 1, 1); PG8_SCHED; PG8_LDA(At, 1, 0); PG8_STAGE(PG8_SA(0, 1), a2, vo[1]);
            PG8_WAIT_V(8); PG8_WAIT_L(0); PG8_BAR; PG8_MMA(0, 0, At, B0); PG8_MMA(0, 1, At, B1); PG8_BAR; PG8_SCHED;
            PG8_LDA(At, 1, 1); PG8_STAGE(PG8_SB(1, 0), b3, voffB); PG8_STAGE(PG8_SB(1, 1), b3 + hstepB, voffB); PG8_STAGE(PG8_SA(1, 0), a3, vo[0]);
            PG8_WAIT_V(8); PG8_WAIT_L(0); PG8_BAR; if (full) { PG8_MMA(1, 0, At, B0); PG8_MMA(1, 1, At, B1); } PG8_BAR; PG8_SCHED;
        }
        if constexpr (ALIGN_EPI) { if (wr == 0) PG8_BAR; }
        E(acc, cur, wr, wc, fr, fq);
        if (!has_next) break;
#pragma unroll
        for (int a = 0; a < 2; ++a)
#pragma unroll
            for (int b = 0; b < 2; ++b)
#pragma unroll
                for (int m = 0; m < 4; ++m)
#pragma unroll
                    for (int n = 0; n < 2; ++n) acc[a][b][m][n] = (f32x4){0.f, 0.f, 0.f, 0.f};
        cur = nxt; ++ui;
        if constexpr (ALIGN_EPI) { if (wr == 1) PG8_BAR; }
    }
    PG8_WAIT_V(0);
    if constexpr (!ALIGN_EPI) { if (wr == 0) PG8_BAR; }
    PG8_BAR;
#undef PG8_SA
#undef PG8_SB
#undef PG8_STAGE
#undef PG8_LDA
#undef PG8_LDB
#undef PG8_MMA
#undef PG8_WAIT_V
#undef PG8_WAIT_L
#undef PG8_BAR
#undef PG8_SCHED
}

template <bool ODD> struct EpiZ {
    static constexpr bool PERM = true;
    bf16_t* Z; float* vstat; const float* rstd;
    __device__ __forceinline__ void operator()(const f32x4 (&acc)[2][2][4][2], const Unit& u, int wr, int wc, int fr, int fq) const {
        const int row0 = u.rowbase + wr * 64 + fr; const int col0 = u.pn * BM + wc * 32 + 8 * fq;
        float rsv[2][4];
#pragma unroll
        for (int ai = 0; ai < 2; ++ai)
#pragma unroll
            for (int m = 0; m < 4; ++m) rsv[ai][m] = rstd[row0 + ai * HALF + m * 16];
#pragma unroll
        for (int ai = 0; ai < 2; ++ai)
#pragma unroll
            for (int m = 0; m < 4; ++m) {
                const int row = row0 + ai * HALF + m * 16;
                bf16_t* rowp = Z + (size_t)row * ZP + col0;
                float s = 0.f, q = 0.f;
#pragma unroll
                for (int bj = 0; bj < 2; ++bj) {
                    f32x4 v0 = acc[ai][bj][m][0] * rsv[ai][m], v1 = acc[ai][bj][m][1] * rsv[ai][m];
                    if (ODD) {
#pragma unroll
                        for (int j = 0; j < 4; ++j) { v0[j] = gelu_tanh(v0[j]); v1[j] = gelu_tanh(v1[j]); s += v0[j] + v1[j]; q += v0[j] * v0[j] + v1[j] * v1[j]; }
                    }
                    u32x4 w; w.x = cvt_pk_bf16(v0[0], v0[1]); w.y = cvt_pk_bf16(v0[2], v0[3]); w.z = cvt_pk_bf16(v1[0], v1[1]); w.w = cvt_pk_bf16(v1[2], v1[3]);
                    *(u32x4*)(rowp + bj * HALF) = w;
                }
                if (ODD) {
                    s += __shfl_xor(s, 16); s += __shfl_xor(s, 32); q += __shfl_xor(q, 16); q += __shfl_xor(q, 32);
                    if (u.pn >= 4 && fq == 0) *(f32x2*)(vstat + ((size_t)row * 16 + (u.pn - 4) * 4 + wc) * 2) = (f32x2){s, q};
                }
            }
    }
};
struct EpiResid {
    static constexpr bool PERM = true;
    const bf16_t* __restrict__ Xin; bf16_t* __restrict__ Xout;
    __device__ __forceinline__ void operator()(const f32x4 (&acc)[2][2][4][2], const Unit& u, int wr, int wc, int fr, int fq) const {
        const int row0 = u.rowbase + wr * 64 + fr, col0 = u.pn * BM + wc * 32 + 8 * fq;
#pragma unroll
        for (int ai = 0; ai < 2; ++ai) {
            u32x4 t[4][2];
#pragma unroll
            for (int m = 0; m < 4; ++m) { const bf16_t* rowp = Xin + (size_t)(row0 + ai * HALF + m * 16) * DM + col0;
#pragma unroll
                for (int bj = 0; bj < 2; ++bj) t[m][bj] = *(const u32x4*)(rowp + bj * HALF); }
#pragma unroll
            for (int m = 0; m < 4; ++m) { bf16_t* rowp = Xout + (size_t)(row0 + ai * HALF + m * 16) * DM + col0;
#pragma unroll
                for (int bj = 0; bj < 2; ++bj) { const f32x4 v0 = acc[ai][bj][m][0], v1 = acc[ai][bj][m][1]; const u32x4 x = t[m][bj]; u32x4 w;
                    w.x = cvt_pk_bf16(bf_lo(x.x) + v0[0], bf_hi(x.x) + v0[1]); w.y = cvt_pk_bf16(bf_lo(x.y) + v0[2], bf_hi(x.y) + v0[3]);
                    w.z = cvt_pk_bf16(bf_lo(x.z) + v1[0], bf_hi(x.z) + v1[1]); w.w = cvt_pk_bf16(bf_lo(x.w) + v1[2], bf_hi(x.w) + v1[3]);
                    *(u32x4*)(rowp + bj * HALF) = w; } }
        }
    }
};
}

struct Args { const float* in[20]; float* out; unsigned char* ws; int ph_lo, ph_hi; };
static_assert(sizeof(Args) == 184, "Args layout");
struct Frame {
    LAS unsigned char* lds;
};
#define F_TID (opaque_tid())
#define F_LANE (opaque_tid() & 63)
#define F_WAVE (__builtin_amdgcn_readfirstlane(opaque_tid() >> 6))
#define F_G ((int)gridDim.x)
#define F_BID ((int)blockIdx.x)
#define CAS __attribute__((address_space(4)))
__device__ __forceinline__ const CAS char* karg_base() { const CAS char* p = (const CAS char*)__builtin_amdgcn_kernarg_segment_ptr(); asm volatile("" : "+s"(p)); return p; }
#define KIN(k) ((const float*)(*(const GAS float* const CAS*)(karg_base() + 8 * (k))))
#define F_WS ((unsigned char*)(*(GAS unsigned char* const CAS*)(karg_base() + 168)))
#define F_X ((float*)(*(GAS float* const CAS*)(karg_base() + 160)))
#define F_CTL ((unsigned*)(F_WS + WS_CTL))

namespace pg4 {
constexpr int BPL = 4352;
struct Unit4 { int rowbase; int pn; int nvalid; int slot; };
__device__ __forceinline__ int off32(int r, int c) { const int ob = (r & 15) * 64 + c * 2; return (r >> 4) * 1024 + (ob ^ (((ob >> 9) & 1) << 5)); }
__device__ __forceinline__ void stage_rc32(int b, int& R, int& C) { const int st = b >> 10, sb = b & 1023, swz = sb ^ (((sb >> 9) & 1) << 5); R = st * 16 + (swz >> 6); C = (swz & 63) >> 1; }

__device__ __forceinline__ void epi_gu4(bf16_t* H, const LAS float* rstd, const f32x4 (&acc)[8][4], const Unit4& u, int wr, int wc, int fr, int fq) {
    asm volatile("" : "+v"(fr), "+v"(fq));
    const int col0 = u.pn * 128 + wc * 32 + 8 * fq;
    const __amdgpu_buffer_rsrc_t hrs = __builtin_amdgcn_make_buffer_rsrc(H, 0, NR_ALLOC * DE * 2, 0x00020000);
#pragma unroll
    for (int m = 0; m < 8; ++m) {
        const int lr = wr * 128 + m * 16 + fr;
        if (lr < u.nvalid) {
            const float rr = rstd[u.slot * 256 + lr];
            const f32x4 g0 = acc[m][0] * rr, g1 = acc[m][1] * rr, u0 = acc[m][2] * rr, u1 = acc[m][3] * rr; u32x4 w;
            w.x = cvt_pk_bf16(silu_f(g0[0]) * u0[0], silu_f(g0[1]) * u0[1]); w.y = cvt_pk_bf16(silu_f(g0[2]) * u0[2], silu_f(g0[3]) * u0[3]);
            w.z = cvt_pk_bf16(silu_f(g1[0]) * u1[0], silu_f(g1[1]) * u1[1]); w.w = cvt_pk_bf16(silu_f(g1[2]) * u1[2], silu_f(g1[3]) * u1[3]);
            __builtin_amdgcn_raw_buffer_store_b128(w, hrs, (unsigned)(((u.rowbase + lr) * DE + col0) * 2), 0,   16);
        }
    }
}
__device__ __forceinline__ void epi_down4(bf16_t* Y, const LAS float* gates, const f32x4 (&acc)[8][4], const Unit4& u, int wr, int wc, int fr, int fq) {
    asm volatile("" : "+v"(fr), "+v"(fq));
    const int col0 = u.pn * 256 + wc * 64 + 16 * fq;
#pragma unroll
    for (int m = 0; m < 8; ++m) {
        const int lr = wr * 128 + m * 16 + fr;
        if (lr < u.nvalid) {
            const float g = gates[u.slot * 256 + lr];
#pragma unroll
            for (int n2 = 0; n2 < 2; ++n2) { const f32x4 v0 = acc[m][2 * n2] * g, v1 = acc[m][2 * n2 + 1] * g; u32x4 w;
                w.x = cvt_pk_bf16(v0[0], v0[1]); w.y = cvt_pk_bf16(v0[2], v0[3]); w.z = cvt_pk_bf16(v1[0], v1[1]); w.w = cvt_pk_bf16(v1[2], v1[3]);
                *(u32x4*)(Y + (size_t)(u.rowbase + lr) * DM + col0 + 8 * n2) = w; }
        }
    }
}
template <int MODE  , int NT  , int LDB>
__device__ __forceinline__ void gemm4_phase(LAS unsigned char* lds, const LAS int* tab, const LAS unsigned short* toks, const LAS float* gates  , const char* Abase, const float* W0, const float* W1, const float* Gk, bf16_t* Out, const int layer, const int nunits) {
    const int tid = opaque_tid(), wid = __builtin_amdgcn_readfirstlane(tid >> 6), lane = tid & 63, wr = wid >> 2, wc = wid & 3, fr = lane & 15, fq = lane >> 4;
    if (nunits <= 0) return;
    constexpr int ABLK = 32768, BOFF = 3 * ABLK, BSTG = 4 * BPL;
    const unsigned ldsw = (unsigned)wid * 1024u;
    const int aoff = wr * 16384 + pg8::lds_byte(fr, fq * 8);
    const int boff = BOFF + fq * BPL + ((fr & 3) * 68 + ((wc * 64 + fr) >> 2)) * 16;
    const int kg = wid, ng = lane;
    const unsigned bw0 = (unsigned)(BOFF + (kg >> 1) * BPL + ng * 16 + 8 * (kg & 1));
    const int bsel = MODE == 0 ? ((ng >> 3) & 1) : 0;
    const int bcolv = MODE == 0 ? (32 * (ng >> 4) + 8 * (ng & 3) + 4 * ((ng >> 2) & 1)) : (64 * (ng >> 4) + 16 * (ng & 3) + 4 * ((ng >> 2) & 3));
    const unsigned bthr = (unsigned)((4 * kg * LDB + bcolv) * 4);
    const int TT = nunits * NT;
    Unit4 uc; int sa = 0, sb = 0, sc2 = 0, ka = 0, kb = 0, kc = 0;
#define G4_NEXTC(i) do { uc.rowbase = __builtin_amdgcn_readfirstlane(tab[(i) * 8 + 3]); uc.nvalid = __builtin_amdgcn_readfirstlane(tab[(i) * 8 + 4]); uc.pn = __builtin_amdgcn_readfirstlane(tab[(i) * 8 + 2]); uc.slot = (i); } while (0)
#define G4_NEXTA(i) do { if (MODE == 0) curA = Abase; else curA = Abase + (size_t)__builtin_amdgcn_readfirstlane(tab[(i) * 8 + 3]) * DE * 2; \
        _Pragma("unroll") for (int _h = 0; _h < 2; ++_h) _Pragma("unroll") for (int _i = 0; _i < 2; ++_i) { int _R, _C; pg8::stage_rc(tid * 16 + _i * 8192, _R, _C); \
            vo[_h][_i] = MODE == 0 ? (unsigned)(((int)toks[(i) * 256 + _h * 128 + _R] * DM + _C) * 2) : (unsigned)(((_h * 128 + _R) * DE + _C) * 2); } } while (0)
#define G4_NEXTB(i) do { const int _e = __builtin_amdgcn_readfirstlane(tab[(i) * 8 + 0]), _ct = __builtin_amdgcn_readfirstlane(tab[(i) * 8 + 2]); \
        if (MODE == 0) { const size_t _wo = (size_t)(layer * NE + _e) * DM * DE + (size_t)_ct * 128; curB0 = W0 + _wo; curB1 = W1 + _wo; } \
        else { curB0 = W0 + (size_t)(layer * NE + _e) * DE * DM + (size_t)_ct * 256; curB1 = curB0; } } while (0)
    const char* curA; const float* curB0; const float* curB1; unsigned vo[2][2];
    G4_NEXTC(0); G4_NEXTA(0); G4_NEXTB(0);
    f32x4 acc[8][4];
#pragma unroll
    for (int m = 0; m < 8; ++m)
#pragma unroll
        for (int n = 0; n < 4; ++n) acc[m][n] = (f32x4){0.f, 0.f, 0.f, 0.f};
    f32x4 Br[3][4];
#define G4_ISSUE_A(blk) do { const char* _ap = curA + (size_t)ka * 128; \
        _Pragma("unroll") for (int _h = 0; _h < 2; ++_h) _Pragma("unroll") for (int _i = 0; _i < 2; ++_i) \
            __builtin_amdgcn_global_load_lds((const unsigned*)(_ap + vo[_h][_i]), (LAS unsigned*)(lds + (blk) * ABLK + _h * 16384 + ldsw + _i * 8192), 16, 0, 0); \
        if (++ka == NT / 2) { ka = 0; if (sa + 1 < nunits) { ++sa; G4_NEXTA(sa); } } } while (0)
#define G4_ISSUE_B(rs) do { const char* _bp = (const char*)(bsel ? curB1 : curB0) + (size_t)kb * (32 * LDB * 4) + bthr; \
        _Pragma("unroll") for (int _j = 0; _j < 4; ++_j) { const char* _p = _bp + (size_t)_j * (LDB * 4); \
            asm volatile("global_load_dwordx4 %0, %1, off ; G4_BLOAD" : "=&v"(Br[rs][_j]) : "v"(_p) : "memory"); } \
        if (++kb == NT) { kb = 0; if (sb + 1 < nunits) { ++sb; G4_NEXTB(sb); } } } while (0)
    f32x4 gq[2] = {(f32x4){1.f, 1.f, 1.f, 1.f}, (f32x4){1.f, 1.f, 1.f, 1.f}};
#define G4_LOAD_G(q, kstep) do { if (MODE == 0) { const float* _gp = Gk + (((kstep) & (NT - 1)) * 32 + 4 * kg); asm volatile("s_load_dwordx4 %0, %1, 0x0" : "=s"(gq[q]) : "s"(_gp) : "memory"); } } while (0)
#define G4_FENCE_G() do { if (MODE == 0) asm volatile("" : "+s"(gq[0]), "+s"(gq[1])); } while (0)
#define G4_WRITE_B(rs, bst, q) do { _Pragma("unroll") for (int _i = 0; _i < 4; ++_i) { u32x2 _w; \
        if (MODE == 0) { _w.x = cvt_pk_bf16(Br[rs][0][_i] * gq[q][0], Br[rs][1][_i] * gq[q][1]); _w.y = cvt_pk_bf16(Br[rs][2][_i] * gq[q][2], Br[rs][3][_i] * gq[q][3]); } \
        else { _w.x = cvt_pk_bf16(Br[rs][0][_i], Br[rs][1][_i]); _w.y = cvt_pk_bf16(Br[rs][2][_i], Br[rs][3][_i]); } \
        *(LAS u32x2*)(lds + (bst) * BSTG + bw0 + 1088 * _i) = _w; } } while (0)
#define G4_WAIT_V(n) asm volatile("s_waitcnt vmcnt(" #n ")" ::: "memory")
#define G4_WAIT_L(n) asm volatile("s_waitcnt lgkmcnt(" #n ")" ::: "memory")
    G4_LOAD_G(0, 0); G4_LOAD_G(1, 1);
    G4_ISSUE_B(0); G4_WAIT_V(0); G4_WAIT_L(0); G4_FENCE_G(); G4_WRITE_B(0, 0, 0); G4_ISSUE_A(0); G4_ISSUE_A(1); G4_ISSUE_B(1); G4_ISSUE_B(2);
    G4_WAIT_V(12);
    int pendT = 0, pendB = 0; bool act0 = (wr < 1) || uc.nvalid > 128;
    int T = 0;
    bf16x8 Bf[4], Af[4];
#pragma unroll
    for (int i = 0; i < 4; ++i) { Bf[i] = (bf16x8){0, 0, 0, 0, 0, 0, 0, 0}; Af[i] = (bf16x8){0, 0, 0, 0, 0, 0, 0, 0}; }
#define G4_WAIT_TOP() do { if (pendT) { if (MODE == 0) G4_WAIT_V(28); else G4_WAIT_V(36); --pendT; } else G4_WAIT_V(20); } while (0)
#define G4_WAIT_B() do { if (pendB) { if (MODE == 0) G4_WAIT_V(16); else G4_WAIT_V(24); --pendB; } else G4_WAIT_V(8); } while (0)
#define G4_STEP(ab, p, rs) do { \
        if ((p) == 0) { G4_WAIT_TOP(); } \
        G4_WAIT_L(0); G4_FENCE_G(); __builtin_amdgcn_s_barrier(); \
        if ((p) == 0) { G4_ISSUE_A(((ab) + 2) % 3); } \
        if (act0) { \
            _Pragma("unroll") for (int n = 0; n < 4; ++n) Bf[n] = *(const LAS bf16x8*)(lds + (p) * BSTG + boff + n * 64); \
            _Pragma("unroll") for (int m = 0; m < 4; ++m) Af[m] = *(const LAS bf16x8*)(lds + (ab) * ABLK + aoff + m * 2048 + (p) * 1024); } \
        G4_WAIT_B(); asm volatile("; G4_BWAIT" ::: "memory"); \
        G4_WRITE_B(((rs) + 1) % 3, 1 - (p), 1 - (p)); G4_LOAD_G(p, T + 2); \
        G4_ISSUE_B(rs); \
        if (act0) { __builtin_amdgcn_s_setprio(1); \
            _Pragma("unroll") for (int m = 0; m < 4; ++m) _Pragma("unroll") for (int n = 0; n < 4; ++n) acc[m][n] = __builtin_amdgcn_mfma_f32_16x16x32_bf16(Bf[n], Af[m], acc[m][n], 0, 0, 0); \
            __builtin_amdgcn_s_setprio(0); \
            _Pragma("unroll") for (int m = 0; m < 4; ++m) Af[m] = *(const LAS bf16x8*)(lds + (ab) * ABLK + aoff + (m + 4) * 2048 + (p) * 1024); \
            __builtin_amdgcn_s_setprio(1); \
            _Pragma("unroll") for (int m = 0; m < 4; ++m) _Pragma("unroll") for (int n = 0; n < 4; ++n) acc[m + 4][n] = __builtin_amdgcn_mfma_f32_16x16x32_bf16(Bf[n], Af[m], acc[m + 4][n], 0, 0, 0); \
            __builtin_amdgcn_s_setprio(0); } \
        if (++kc == NT) { kc = 0; \
            if (MODE == 0) epi_gu4(Out, gates, acc, uc, wr, wc, fr, fq); else epi_down4(Out, gates, acc, uc, wr, wc, fr, fq); \
            if (wr < 1 || uc.nvalid > 128) { pendT = 2; pendB = 2; } else { pendT = 0; pendB = 0; } \
            _Pragma("unroll") for (int m = 0; m < 8; ++m) _Pragma("unroll") for (int n = 0; n < 4; ++n) acc[m][n] = (f32x4){0.f, 0.f, 0.f, 0.f}; \
            if (sc2 + 1 < nunits) { ++sc2; G4_NEXTC(sc2); act0 = (wr < 1) || uc.nvalid > 128; } } \
        ++T; } while (0)
    while (T + 6 <= TT) { G4_STEP(0, 0, 0); G4_STEP(0, 1, 1); G4_STEP(1, 0, 2); G4_STEP(1, 1, 0); G4_STEP(2, 0, 1); G4_STEP(2, 1, 2); }
    if (T + 2 <= TT) { G4_STEP(0, 0, 0); G4_STEP(0, 1, 1);
        if (T + 2 <= TT) { G4_STEP(1, 0, 2); G4_STEP(1, 1, 0); } }
    G4_WAIT_V(0); G4_WAIT_L(0); __builtin_amdgcn_s_barrier();
#pragma unroll
    for (int rs = 0; rs < 3; ++rs)
#pragma unroll
        for (int j = 0; j < 4; ++j) asm volatile("" :: "v"(Br[rs][j]));
#undef G4_NEXTA
#undef G4_NEXTB
#undef G4_NEXTC
#undef G4_ISSUE_A
#undef G4_ISSUE_B
#undef G4_WRITE_B
#undef G4_LOAD_G
#undef G4_FENCE_G
#undef G4_WAIT_V
#undef G4_WAIT_L
#undef G4_WAIT_TOP
#undef G4_WAIT_B
#undef G4_STEP
}
}

struct MoeTabs { LAS int* cnt; LAS int* seg; LAS int* fst; LAS int* hst; LAS int* tab; LAS int* nmy; LAS unsigned short* toks; LAS float* gates; LAS float* rstd; };
__device__ __forceinline__ MoeTabs moe_tabs(Frame& F) {
    MoeTabs T; LAS unsigned char* m = F.lds + MISC_OFF;
    T.cnt = (LAS int*)(m + MO_CNT); T.seg = (LAS int*)(m + MO_SEG); T.fst = (LAS int*)(m + MO_FST); T.hst = (LAS int*)(m + MO_HST); T.tab = (LAS int*)(m + MO_TAB); T.nmy = (LAS int*)(m + MO_NMY);
    T.toks = (LAS unsigned short*)(m + MO_TOKS); T.gates = (LAS float*)(m + MO_GATES); T.rstd = (LAS float*)(m + MO_RSTD); return T;
}
__device__ __forceinline__ void moe_build_seg(Frame& F, const Args& AR, const MoeTabs& T, int layer) {
    __syncthreads();
    if (F_TID < NE) T.cnt[F_TID] = (int)__hip_atomic_load(F_CTL + CW_CNT + (layer * NE + F_TID) * 64, __ATOMIC_RELAXED, __HIP_MEMORY_SCOPE_AGENT);
    __syncthreads();
    if (F_TID < NE) {
        const int e = F_TID, c = T.cnt[e], nb = (c + 127) >> 7;
        int s = nb * 128, fs = (nb >> 1) * 4, hs = (nb & 1) * 4;
        const int s0 = s, f0 = fs, h0 = hs;
#pragma unroll
        for (int o = 1; o < 64; o <<= 1) { const int a = __shfl_up(s, o), b = __shfl_up(fs, o), d = __shfl_up(hs, o); if (e >= o) { s += a; fs += b; hs += d; } }
        T.seg[e] = s - s0; T.fst[e] = fs - f0; T.hst[e] = hs - h0;
        if (e == NE - 1) { T.seg[NE] = s; T.fst[NE] = fs; T.hst[NE] = hs; }
    }
    __syncthreads();
}
__device__ __forceinline__ int moe_build_units(Frame& F, const Args& AR, const MoeTabs& T, int layer, int base, bool build, const int nfull, const int total, const bool deal2, int& nfw, const int sl0 = 0  ) {
    const int vcu = (F_G % 8 == 0) ? (F_BID % 8) * (F_G / 8) + F_BID / 8 : F_BID;
    int n = (total - base - vcu + F_G - 1) / F_G; n = n < 0 ? 0 : (n > MAXU ? MAXU : n);
    const int rv = F_G - 1 - vcu;
    nfw = (nfull - vcu + F_G - 1) / F_G; nfw = nfw < 0 ? 0 : (nfw > MAXU ? MAXU : nfw);
    if (deal2) { int nhw = (total - nfull - rv + F_G - 1) / F_G; nhw = nhw < 0 ? 0 : nhw; n = nfw + nhw; n = n > MAXU ? MAXU : n; }
    if (!build) return n;
    if (F_TID < 64) {
        const int e = F_TID; const int fa = T.fst[e], fb = T.fst[e + 1], ha = T.hst[e], hb = T.hst[e + 1];
#pragma unroll
        for (int i = 0; i < MAXU; ++i) {
            if (i >= sl0 && i < n) {
                const int L = deal2 ? (i < nfw ? i * F_G + vcu : nfull + (i - nfw) * F_G + rv) : base + i * F_G + vcu;
                const bool isf = L < nfull; const int Lr = isf ? L : L - nfull;
                const bool mine = isf ? (fa <= Lr && Lr < fb) : (ha <= Lr && Lr < hb);
                const unsigned long long mk = __ballot(mine);
                const int ee = (int)__builtin_ctzll(mk);
                if (e == ee) { const int r = Lr - (isf ? fa : ha), c = T.cnt[e]; const int nb = (c + 127) >> 7;
                    const int rb = isf ? (r >> 2) : (nb >> 1), ct = r & 3;
                    LAS int* t = T.tab + i * 8; t[0] = e; t[1] = rb; t[2] = ct; t[3] = T.seg[e] + rb * 256; t[4] = isf ? 256 : 128; t[5] = c - rb * 256; }
            }
        }
    }
    __syncthreads();
    const i32x4* list = (const i32x4*)(F_WS + WS_LIST);
    {
        const int tid = F_TID, row = tid & 255, sh = tid >> 8;
        i32x4 v[MAXU / 2];
#pragma unroll
        for (int p = 0; p < MAXU / 2; ++p) { const int sl = 2 * p + sh; v[p] = (i32x4){ZERO_ROW, 0, 0, 0};
            if (sl >= sl0 && sl < n) { const int e = T.tab[sl * 8 + 0], rb = T.tab[sl * 8 + 1], cl = T.tab[sl * 8 + 5];
                if (row < cl) v[p] = list[(size_t)e * NT + rb * 256 + row]; } }
#pragma unroll
        for (int p = 0; p < MAXU / 2; ++p) { const int sl = 2 * p + sh;
            if (sl >= sl0 && sl < n) { const int vx = v[p].x, vy = v[p].y, vz = v[p].z; T.toks[sl * 256 + row] = (unsigned short)vx; T.gates[sl * 256 + row] = __int_as_float(vy); T.rstd[sl * 256 + row] = __int_as_float(vz); } }
    }
    __syncthreads();
    return n;
}
constexpr int BLK_CTRS = 384;
__device__ __forceinline__ bool moe_fusable(int nfull, int total, int G) { return total <= MAXU * G && ((nfull + G - 1) / G + (total - nfull + G - 1) / G) <= MAXU; }
__device__ __forceinline__ void moe_publish(Frame& F, const Args& AR, const MoeTabs& T, int layer, int n) {
    if (F_TID < 64) {
        if (F_TID < n) { unsigned* c = F_CTL + CW_BLK + ((size_t)layer * BLK_CTRS + (T.tab[F_TID * 8 + 3] >> 7)) * 16; (void)xb_add(c, 1u); }
    }
}
__device__ __forceinline__ void moe_wait(Frame& F, const Args& AR, const MoeTabs& T, int layer, int s0, int s1) {
    if (F_TID < 64) {
        const int i = s0 + F_TID;
        if (i < s1) { unsigned* c = F_CTL + CW_BLK + ((size_t)layer * BLK_CTRS + (T.tab[i * 8 + 3] >> 7)) * 16; unsigned* bar = F_CTL + CW_BAR;
            XB_SPIN(xb_ld(c) < 4u, bar); }
        if (F_TID == 0) __builtin_amdgcn_fence(__ATOMIC_ACQUIRE, "agent");
    }
    asm volatile("s_waitcnt vmcnt(0)" ::: "memory");
    __syncthreads();
}
__device__ __forceinline__ unsigned f2bf(float f) { unsigned u = __builtin_bit_cast(unsigned, f); return (u + 0x7fffu + ((u >> 16) & 1u)) >> 16; }
__device__ __forceinline__ unsigned pk2(float lo, float hi) { return f2bf(lo) | (f2bf(hi) << 16); }
__device__ __forceinline__ void p0_transpose_item(const float* W, int N, bf16_t* WT, int Kd, int k0, int n0, int drow0, LAS float* scr, int lane, const float* gk) {
#pragma unroll 8
    for (int i = 0; i < 32; ++i) { const int kk = 2 * i + (lane >> 5); scr[kk * 33 + (lane & 31)] = W[(size_t)(k0 + kk) * N + n0 + (lane & 31)]; }
    LDS_WAIT(); asm volatile("" ::: "memory");
    const int c = lane & 7;
    f32x4 g0 = (f32x4){1.f, 1.f, 1.f, 1.f}, g1 = g0;
    if (gk) { g0 = *(const f32x4*)(gk + k0 + 8 * c); g1 = *(const f32x4*)(gk + k0 + 8 * c + 4); }
#pragma unroll
    for (int j = 0; j < 4; ++j) { const int n = (lane >> 3) + 8 * j; const LAS float* s = scr + (8 * c) * 33 + n;
        u32x4 o; o.x = pk2(s[0 * 33] * g0.x, s[1 * 33] * g0.y); o.y = pk2(s[2 * 33] * g0.z, s[3 * 33] * g0.w); o.z = pk2(s[4 * 33] * g1.x, s[5 * 33] * g1.y); o.w = pk2(s[6 * 33] * g1.z, s[7 * 33] * g1.w);
        *(u32x4*)(WT + (size_t)(drow0 + n) * Kd + k0 + 8 * c) = o; }
    LDS_WAIT(); asm volatile("" ::: "memory");
}
__device__ __forceinline__ void row_rstd(const f32x4 (&v)[4], int lane, float* out) {
    float s = 0.f;
#pragma unroll
    for (int j = 0; j < 4; ++j) s += (v[j].x * v[j].x + v[j].y * v[j].y) + (v[j].z * v[j].z + v[j].w * v[j].w);
    const float rstd = 1.0f / sqrtf(wave_sum(s) * (1.f / DM) + EPS);
    if (lane == 0) *out = rstd;
}
__device__ __forceinline__ void norm_row(const f32x4 (&v)[4], const float* g, int lane, bf16_t* ob, float* of, float oscale = 1.0f) {
    float s = 0.f;
#pragma unroll
    for (int j = 0; j < 4; ++j) s += (v[j].x * v[j].x + v[j].y * v[j].y) + (v[j].z * v[j].z + v[j].w * v[j].w);
    const float rstd = oscale / sqrtf(wave_sum(s) * (1.f / DM) + EPS);
#pragma unroll
    for (int j = 0; j < 4; ++j) {
        const f32x4 gg = *((const f32x4*)g + lane + 64 * j);
        const f32x4 y = v[j] * rstd * gg;
        if (ob) { u32x2 w; w.x = cvt_pk_bf16(y.x, y.y); w.y = cvt_pk_bf16(y.z, y.w); *((u32x2*)ob + lane + 64 * j) = w; }
        if (of) *((f32x4*)of + lane + 64 * j) = y;
    }
}
__device__ __forceinline__ void p0_prologue(Frame& F, const Args& AR) {
    LAS float* scr = (LAS float*)(F.lds + F_WAVE * 16384);
    const int gw = F_BID * NWAVES + F_WAVE, NGW = F_G * NWAVES;
    bf16_t* WIN = (bf16_t*)(F_WS + WS_WIN); bf16_t* WOUT = (bf16_t*)(F_WS + WS_WOUT);
    constexpr int I_IN = 16 * 64, I_OUT = 16 * 32, I_MIX = NL * (I_IN + I_OUT);
    for (int it = gw; it < I_MIX; it += NGW) {
        if (it < NL * I_IN) { const int l = it / I_IN, r = it % I_IN, kb = r / 64, nb = r % 64;
            const float* W = ((l & 1) ? KIN(8) : KIN(4)) + (size_t)(l >> 1) * DM * 2048;
            p0_transpose_item(W, 2048, WIN + (size_t)l * 2048 * DM, DM, kb * 64, nb * 32, nb * 32, scr, F_LANE, KIN(1) + (size_t)l * DM); continue; }
        const int q = it - NL * I_IN, l = q / I_OUT, r = q % I_OUT, kb = r / 32, nb = r % 32;
        const float* W = ((l & 1) ? KIN(12) : KIN(5)) + (size_t)(l >> 1) * DM * DM;
        p0_transpose_item(W, DM, WOUT + (size_t)l * DM * DM, DM, kb * 64, nb * 32, nb * 32, scr, F_LANE, nullptr);
    }
    {
        bf16_t* WSB = (bf16_t*)(F_WS + WS_WSB); bf16_t* PWT = (bf16_t*)(F_WS + WS_PWT);
        const int gt = F_BID * NTHR + F_TID, NGT = F_G * NTHR;
        for (int i = gt; i < 2 * 8 * 128 * 128; i += NGT) { const int jj = i & 127, ii = (i >> 7) & 127; const float v = (jj <= ii) ? KIN(10)[i] : 0.f; WSB[i] = (bf16_t)f2bf(v); }
        bf16_t* WRH = (bf16_t*)(F_WS + WS_WRT); bf16_t* WRL = WRH + NL * 80 * 1024;
        for (int i = gt; i < NL * 80 * 1024; i += NGT) { const int k = i & 1023, n = (i >> 10) % 80, l = i / 81920;
            const float w = (n < 8 ? KIN(13)[((size_t)l * 1024 + k) * 8 + n] : (n < 72 ? KIN(15)[((size_t)l * 1024 + k) * 64 + n - 8] : 0.f)) * KIN(2)[l * 1024 + k];
            const unsigned hi = f2bf(w); const float rem = w - bf_lo(hi);
            WRH[i] = (bf16_t)hi; WRL[i] = (bf16_t)f2bf(rem); }
        for (int i = gt; i < 2 * 4 * 128 * 128; i += NGT) { const int c = i & 127, d = (i >> 7) & 127, lg2 = i >> 14; PWT[i] = (bf16_t)f2bf(KIN(6)[(size_t)lg2 * 16384 + c * 128 + d]); }
    }
    bf16_t* XBz = (bf16_t*)(F_WS + WS_XB);
    for (int m = gw; m < NT; m += NGW) {
        const f32x4* xr = (const f32x4*)(KIN(0) + (size_t)m * DM) + F_LANE; f32x4 v[4];
#pragma unroll
        for (int j = 0; j < 4; ++j) { v[j] = xr[64 * j]; u32x2 w; w.x = cvt_pk_bf16(v[j].x, v[j].y); w.y = cvt_pk_bf16(v[j].z, v[j].w); *((u32x2*)((bf16_t*)(F_WS + WS_X16) + (size_t)m * DM) + F_LANE + 64 * j) = w; }
        row_rstd(v, F_LANE, (float*)(F_WS + WS_RSTD) + m);
    }
    if (gw == 0) { for (int j = 0; j < 4; ++j) *((u32x2*)(XBz + (size_t)ZERO_ROW * DM) + F_LANE + 64 * j) = (u32x2){0u, 0u}; }
}

typedef float f32x16 __attribute__((ext_vector_type(16)));
typedef short s16x4 __attribute__((ext_vector_type(4)));
constexpr int ATT_RS = 144;
constexpr int ATT_VBUF = 32 * ATT_RS;
__device__ __forceinline__ void attn_mfma(Frame& F, const Args& AR) {
    const bf16_t* Z = (const bf16_t*)(F_WS + WS_Z); bf16_t* YM = (bf16_t*)(F_WS + WS_YM);
    const int lane = F_LANE, l31 = lane & 31, hh = lane >> 5;
    LAS unsigned char* vbuf = F.lds + F_WAVE * (3 * ATT_VBUF);
    LAS unsigned char* kbuf = vbuf + 2 * ATT_VBUF;
    const int gi = (lane >> 4) & 1, q4 = (lane & 15) >> 2, p4 = lane & 3;
    const unsigned troff = (unsigned)((4 * hh + q4) * ATT_RS + (16 * gi + 4 * p4) * 2);
    const int vr8 = lane >> 3, vcol = lane & 7;
    const float SC = 0.125f * 1.4426950408889634f;
    const int NJOB = 2048, W0 = F_BID * NWAVES + F_WAVE, NW = F_G * NWAVES;
    for (int job = W0; job < NJOB; job += NW) {
        const int bh = job >> 5, b = bh >> 3, head = bh & 7, gp = (job >> 2) & 7, r = job & 3;
        for (int half = 0; half < 2; ++half) {
            const int g = half ? 15 - gp : gp;
            const int tq = b * SEQ + 128 * g + 4 * l31 + r;
            bf16x8 Qf[4];
#pragma unroll
            for (int s2 = 0; s2 < 4; ++s2) Qf[s2] = *(const bf16x8*)(Z + (size_t)tq * ZP + 512 + head * 64 + 16 * s2 + 8 * hh);
            f32x16 O0, O1;
#pragma unroll
            for (int i = 0; i < 16; ++i) { O0[i] = 0.f; O1[i] = 0.f; }
            float m = -INFINITY, l = 0.f;
            const int nA0 = (g == 0) ? 4 : 0, nA = 8 - nA0, nblk = nA + g + 1;
            u32x4 Kn[4]; u32x4 Vn[4];
            { const int kstart = 128 * g - 128 + 32 * nA0;
              const bf16_t* kp = Z + (size_t)(b * SEQ + kstart + vr8) * ZP + 1024 + head * 64 + 8 * vcol;
#pragma unroll
              for (int c4 = 0; c4 < 4; ++c4) Kn[c4] = *(const u32x4*)(kp + (size_t)c4 * 8 * ZP);
              const bf16_t* vp = Z + (size_t)(b * SEQ + kstart + vr8) * ZP + 1536 + head * 64 + 8 * vcol;
#pragma unroll
              for (int c4 = 0; c4 < 4; ++c4) Vn[c4] = *(const u32x4*)(vp + (size_t)c4 * 8 * ZP); }
            for (int n = 0; n < nblk; ++n) {
                const bool passA = n < nA;
                const int kstart = passA ? (128 * g - 128 + 32 * (nA0 + n)) : 32 * (n - nA);
                bf16x8 Kc[4];
#pragma unroll
                for (int c4 = 0; c4 < 4; ++c4) *(LAS u32x4*)(kbuf + (8 * c4 + vr8) * ATT_RS + vcol * 16) = Kn[c4];
#pragma unroll
                for (int s2 = 0; s2 < 4; ++s2) Kc[s2] = *(const LAS bf16x8*)(kbuf + l31 * ATT_RS + (16 * s2 + 8 * hh) * 2);
                LAS unsigned char* vb = vbuf + (n & 1) * ATT_VBUF;
#pragma unroll
                for (int c4 = 0; c4 < 4; ++c4) *(LAS u32x4*)(vb + (8 * c4 + vr8) * ATT_RS + vcol * 16) = Vn[c4];
                if (n + 1 < nblk) {
                    const int n1 = n + 1; const bool pA = n1 < nA;
                    const int ks1 = pA ? (128 * g - 128 + 32 * (nA0 + n1)) : 32 * (n1 - nA);
                    const int tv = pA ? (b * SEQ + ks1 + vr8) : (b * SEQ + 4 * (ks1 + vr8) + r);
                    const bf16_t* vp = Z + (size_t)tv * ZP + 1536 + head * 64 + 8 * vcol; const size_t vstep = (size_t)(pA ? 8 : 32) * ZP;
                    const bf16_t* kp = vp - 512;
#pragma unroll
                    for (int c4 = 0; c4 < 4; ++c4) Kn[c4] = *(const u32x4*)(kp + c4 * vstep);
#pragma unroll
                    for (int c4 = 0; c4 < 4; ++c4) Vn[c4] = *(const u32x4*)(vp + c4 * vstep);
                }
                f32x16 S;
#pragma unroll
                for (int i = 0; i < 16; ++i) S[i] = 0.f;
#pragma unroll
                for (int s2 = 0; s2 < 4; ++s2) S = __builtin_amdgcn_mfma_f32_32x32x16_bf16(Kc[s2], Qf[s2], S, 0, 0, 0);
                const int qpos = passA ? (128 * g + 4 * l31 + r) : (32 * g + l31);
                const int dbase = qpos - kstart - 4 * hh;
                float bm = -INFINITY; float P[16];
                if (passA) {
#pragma unroll
                    for (int i = 0; i < 16; ++i) { const int d = dbase - ((i & 3) + 8 * (i >> 2));
                        const float sv = ((unsigned)d <= 128u) ? S[i] * SC : -INFINITY; S[i] = sv; bm = fmaxf(bm, sv); }
                } else {
#pragma unroll
                    for (int i = 0; i < 16; ++i) { const int d = dbase - ((i & 3) + 8 * (i >> 2));
                        const bool v1 = (unsigned)d <= 128u, v2 = d >= 0 && (d & 3) == 0;
                        const float sv = (v1 || v2) ? S[i] * SC + ((v1 && v2) ? 1.0f : 0.0f) : -INFINITY; S[i] = sv; bm = fmaxf(bm, sv); }
                }
                bm = fmaxf(bm, __shfl_xor(bm, 32));
                if (__builtin_amdgcn_ballot_w64(bm > m) != 0ull) {
                    const float mnew = fmaxf(m, bm);
                    const float msafe0 = (mnew == -INFINITY) ? 0.f : mnew;
                    const float alpha = __builtin_amdgcn_exp2f(m - msafe0);
                    m = mnew; l *= alpha;
#pragma unroll
                    for (int i = 0; i < 16; ++i) { O0[i] *= alpha; O1[i] *= alpha; }
                }
                const float msafe = (m == -INFINITY) ? 0.f : m;
                float ps = 0.f;
#pragma unroll
                for (int i = 0; i < 16; ++i) { const float p = __builtin_amdgcn_exp2f(S[i] - msafe); P[i] = p; ps += p; }
                l += ps;
                bf16x8 Pf[2];
#pragma unroll
                for (int s2 = 0; s2 < 2; ++s2) {
                    u32x4 pk; pk.x = cvt_pk_bf16(P[8 * s2 + 0], P[8 * s2 + 1]); pk.y = cvt_pk_bf16(P[8 * s2 + 2], P[8 * s2 + 3]);
                    pk.z = cvt_pk_bf16(P[8 * s2 + 4], P[8 * s2 + 5]); pk.w = cvt_pk_bf16(P[8 * s2 + 6], P[8 * s2 + 7]);
                    Pf[s2] = __builtin_bit_cast(bf16x8, pk);
                }
                const unsigned va = (unsigned)(size_t)vb + troff;
                s16x4 v000, v001, v010, v011, v100, v101, v110, v111;
                asm volatile("s_waitcnt lgkmcnt(0)\n\t"
                             "ds_read_b64_tr_b16 %0, %8\n\t"
                             "ds_read_b64_tr_b16 %1, %8 offset:%9\n\t"
                             "ds_read_b64_tr_b16 %2, %8 offset:%10\n\t"
                             "ds_read_b64_tr_b16 %3, %8 offset:%11\n\t"
                             "ds_read_b64_tr_b16 %4, %8 offset:64\n\t"
                             "ds_read_b64_tr_b16 %5, %8 offset:%12\n\t"
                             "ds_read_b64_tr_b16 %6, %8 offset:%13\n\t"
                             "ds_read_b64_tr_b16 %7, %8 offset:%14\n\t"
                             "s_waitcnt lgkmcnt(0)"
                             : "=&v"(v000), "=&v"(v001), "=&v"(v010), "=&v"(v011), "=&v"(v100), "=&v"(v101), "=&v"(v110), "=&v"(v111)
                             : "v"(va), "n"(8 * ATT_RS), "n"(16 * ATT_RS), "n"(24 * ATT_RS), "n"(64 + 8 * ATT_RS), "n"(64 + 16 * ATT_RS), "n"(64 + 24 * ATT_RS)
                             : "memory");
                bf16x8 A00, A01, A10, A11;
                A00 = (bf16x8){v000[0], v000[1], v000[2], v000[3], v001[0], v001[1], v001[2], v001[3]};
                A01 = (bf16x8){v010[0], v010[1], v010[2], v010[3], v011[0], v011[1], v011[2], v011[3]};
                A10 = (bf16x8){v100[0], v100[1], v100[2], v100[3], v101[0], v101[1], v101[2], v101[3]};
                A11 = (bf16x8){v110[0], v110[1], v110[2], v110[3], v111[0], v111[1], v111[2], v111[3]};
                O0 = __builtin_amdgcn_mfma_f32_32x32x16_bf16(A00, Pf[0], O0, 0, 0, 0);
                O0 = __builtin_amdgcn_mfma_f32_32x32x16_bf16(A01, Pf[1], O0, 0, 0, 0);
                O1 = __builtin_amdgcn_mfma_f32_32x32x16_bf16(A10, Pf[0], O1, 0, 0, 0);
                O1 = __builtin_amdgcn_mfma_f32_32x32x16_bf16(A11, Pf[1], O1, 0, 0, 0);
            }
            l += __shfl_xor(l, 32);
            const float inv = 1.0f / l;
            bf16_t* op = YM + (size_t)tq * DM + 512 + head * 64 + 4 * hh;
#pragma unroll
            for (int k4 = 0; k4 < 4; ++k4) {
                u32x2 w0, w1;
                w0.x = cvt_pk_bf16(O0[4 * k4 + 0] * inv, O0[4 * k4 + 1] * inv); w0.y = cvt_pk_bf16(O0[4 * k4 + 2] * inv, O0[4 * k4 + 3] * inv);
                w1.x = cvt_pk_bf16(O1[4 * k4 + 0] * inv, O1[4 * k4 + 1] * inv); w1.y = cvt_pk_bf16(O1[4 * k4 + 2] * inv, O1[4 * k4 + 3] * inv);
                *(u32x2*)(op + 8 * k4) = w0; *(u32x2*)(op + 32 + 8 * k4) = w1;
            }
        }
    }
    __syncthreads();
}
constexpr int SGU_RS = 272;
__device__ __forceinline__ void sgu_mfma(Frame& F, const Args& AR, int li) {
    const bf16_t* Z = (const bf16_t*)(F_WS + WS_Z); bf16_t* YM = (bf16_t*)(F_WS + WS_YM); const float* VS = (const float*)(F_WS + WS_VSTAT);
    const bf16_t* WSB = (const bf16_t*)(F_WS + WS_WSB) + (size_t)li * 8 * 16384;
    const float* GN = KIN(9) + (size_t)li * DM; const float* BS = KIN(11) + (size_t)li * 8 * 128;
    constexpr int IMG = 128 * SGU_RS;
    const int tid = F_TID, lane = tid & 63, wave = __builtin_amdgcn_readfirstlane(tid >> 6);
    const int l31 = lane & 31, hh = lane >> 5, gi2 = (lane >> 4) & 1, q4 = (lane & 15) >> 2, p4 = lane & 3;
    const int ct = wave & 3, ia = wave >> 2;
    const int sj = tid >> 2, sc0 = (tid & 3) * 32;
    u32x4 sp[4]; f32x2 sst[4];
#define SGU_LOAD(unit_) do { const int _bn = (unit_) >> 3, _g = (unit_) & 7, _tok = _bn * 128 + sj; \
        const f32x2* _st = (const f32x2*)(VS + (size_t)_tok * 32) + (tid & 3) * 4; \
        _Pragma("unroll") for (int _i = 0; _i < 4; ++_i) sst[_i] = _st[_i]; \
        const u32x4* _p = (const u32x4*)(Z + (size_t)_tok * ZP + 1024 + _g * 128 + sc0); \
        _Pragma("unroll") for (int _k = 0; _k < 4; ++_k) sp[_k] = _p[_k]; } while (0)
#define SGU_STORE(unit_, buf_) do { const int _g = (unit_) & 7; float sm = 0.f, sq = 0.f; \
        _Pragma("unroll") for (int _i = 0; _i < 4; ++_i) { sm += sst[_i].x; sq += sst[_i].y; } \
        sm += __shfl_xor(sm, 1); sm += __shfl_xor(sm, 2); sq += __shfl_xor(sq, 1); sq += __shfl_xor(sq, 2); \
        const float mean = sm * (1.f / DM), rstd = 1.0f / sqrtf(sq * (1.f / DM) - mean * mean + EPS); \
        const f32x4* gp4 = (const f32x4*)(GN + _g * 128 + sc0); \
        _Pragma("unroll") for (int _k = 0; _k < 4; ++_k) { const u32x4 a = sp[_k]; const f32x4 g0 = gp4[2 * _k], g1 = gp4[2 * _k + 1]; u32x4 w; \
            w.x = cvt_pk_bf16((bf_lo(a.x) - mean) * rstd * g0.x, (bf_hi(a.x) - mean) * rstd * g0.y); w.y = cvt_pk_bf16((bf_lo(a.y) - mean) * rstd * g0.z, (bf_hi(a.y) - mean) * rstd * g0.w); \
            w.z = cvt_pk_bf16((bf_lo(a.z) - mean) * rstd * g1.x, (bf_hi(a.z) - mean) * rstd * g1.y); w.w = cvt_pk_bf16((bf_lo(a.w) - mean) * rstd * g1.z, (bf_hi(a.w) - mean) * rstd * g1.w); \
            *(LAS u32x4*)(F.lds + (buf_) * IMG + sj * SGU_RS + sc0 * 2 + 16 * _k) = w; } } while (0)
    __syncthreads();
    int unit = F_BID, par = 0;
    if (unit < 1024) { SGU_LOAD(unit); SGU_STORE(unit, 0); }
    __syncthreads();
    for (; unit < 1024; unit += F_G, par ^= 1) {
        const int nxt = unit + F_G;
        if (nxt < 1024) SGU_LOAD(nxt);
        const int bn = unit >> 3, g = unit & 7, tok0 = bn * 128;
        LAS unsigned char* vimg = F.lds + par * IMG;
        bf16x8 Bf[2][8]; u32x2 uu[2][4]; float bsv[2];
#pragma unroll
        for (int ib = 0; ib < 2; ++ib) {
            const int it = 2 * ia + ib;
            const int ns = 2 * it + 2;
            const bf16_t* wrow = WSB + (size_t)g * 16384 + (size_t)(32 * it + l31) * 128 + 8 * hh;
#pragma unroll
            for (int s2 = 0; s2 < 8; ++s2) if (s2 < ns) Bf[ib][s2] = *(const bf16x8*)(wrow + 16 * s2);
            const int i = 32 * it + l31, tok = tok0 + i; bsv[ib] = BS[g * 128 + i];
            const bf16_t* up = Z + (size_t)tok * ZP + g * 128 + 32 * ct + 4 * hh;
#pragma unroll
            for (int k4 = 0; k4 < 4; ++k4) uu[ib][k4] = *(const u32x2*)(up + 8 * k4);
        }
#pragma unroll
        for (int ib = 0; ib < 2; ++ib) {
            const int it = 2 * ia + ib, ns = 2 * it + 2;
            const int i = 32 * it + l31, tok = tok0 + i;
            bf16_t* op = YM + (size_t)tok * DM + g * 128 + 32 * ct + 4 * hh;
            f32x16 C;
#pragma unroll
            for (int q = 0; q < 16; ++q) C[q] = 0.f;
            const unsigned va = (unsigned)(size_t)vimg + (unsigned)((8 * hh + q4) * SGU_RS + (32 * ct + 16 * gi2 + 4 * p4) * 2);
#pragma unroll
            for (int s4 = 0; s4 < 4; ++s4) {
                if (2 * s4 < ns) {
                    s16x4 t0, t1, t2, t3;
                    asm volatile("ds_read_b64_tr_b16 %0, %4\n\tds_read_b64_tr_b16 %1, %4 offset:%5\n\tds_read_b64_tr_b16 %2, %4 offset:%6\n\tds_read_b64_tr_b16 %3, %4 offset:%7\n\ts_waitcnt lgkmcnt(0)"
                                 : "=&v"(t0), "=&v"(t1), "=&v"(t2), "=&v"(t3) : "v"(va + (unsigned)(32 * s4 * SGU_RS)), "n"(4 * SGU_RS), "n"(16 * SGU_RS), "n"(20 * SGU_RS) : "memory");
                    const bf16x8 A0 = (bf16x8){t0[0], t0[1], t0[2], t0[3], t1[0], t1[1], t1[2], t1[3]};
                    const bf16x8 A1 = (bf16x8){t2[0], t2[1], t2[2], t2[3], t3[0], t3[1], t3[2], t3[3]};
                    C = __builtin_amdgcn_mfma_f32_32x32x16_bf16(A0, Bf[ib][2 * s4], C, 0, 0, 0);
                    C = __builtin_amdgcn_mfma_f32_32x32x16_bf16(A1, Bf[ib][2 * s4 + 1], C, 0, 0, 0);
                }
            }
            const float bv = bsv[ib];
#pragma unroll
            for (int k4 = 0; k4 < 4; ++k4) { u32x2 w;
                w.x = cvt_pk_bf16(bf_lo(uu[ib][k4].x) * (C[4 * k4 + 0] + bv), bf_hi(uu[ib][k4].x) * (C[4 * k4 + 1] + bv)); w.y = cvt_pk_bf16(bf_lo(uu[ib][k4].y) * (C[4 * k4 + 2] + bv), bf_hi(uu[ib][k4].y) * (C[4 * k4 + 3] + bv));
                *(u32x2*)(op + 8 * k4) = w; }
        }
        if (nxt < 1024) SGU_STORE(nxt, par ^ 1);
        __syncthreads();
    }
#undef SGU_LOAD
#undef SGU_STORE
}
template <int W>
__device__ __forceinline__ void pool_window(const bf16_t* zp, int t, bf16x8 (&Bf)[8]) {
    const int cntw = (t + 1) < W ? (t + 1) : W; const float inv = 1.0f / (float)cntw;
#pragma unroll
    for (int s2 = 0; s2 < 8; ++s2) {
        u32x4 a[W];
#pragma unroll
        for (int j = 0; j < W; ++j) { const int jj = j < cntw ? j : 0; a[j] = *(const u32x4*)(zp - (size_t)jj * ZP + 16 * s2); }
        float acc[8];
#pragma unroll
        for (int i = 0; i < 8; ++i) acc[i] = 0.f;
#pragma unroll
        for (int j = 0; j < W; ++j) { const float m = j < cntw ? 1.f : 0.f;
            acc[0] += m * bf_lo(a[j].x); acc[1] += m * bf_hi(a[j].x); acc[2] += m * bf_lo(a[j].y); acc[3] += m * bf_hi(a[j].y);
            acc[4] += m * bf_lo(a[j].z); acc[5] += m * bf_hi(a[j].z); acc[6] += m * bf_lo(a[j].w); acc[7] += m * bf_hi(a[j].w); }
        const float s0 = bf_lo(a[0].x), s1 = bf_hi(a[0].x), s2f = bf_lo(a[0].y), s3 = bf_hi(a[0].y), s4 = bf_lo(a[0].z), s5 = bf_hi(a[0].z), s6 = bf_lo(a[0].w), s7 = bf_hi(a[0].w);
        u32x4 pk; pk.x = cvt_pk_bf16(acc[0] * inv - s0, acc[1] * inv - s1); pk.y = cvt_pk_bf16(acc[2] * inv - s2f, acc[3] * inv - s3);
        pk.z = cvt_pk_bf16(acc[4] * inv - s4, acc[5] * inv - s5); pk.w = cvt_pk_bf16(acc[6] * inv - s6, acc[7] * inv - s7);
        Bf[s2] = __builtin_bit_cast(bf16x8, pk);
    }
}
constexpr int POOL_RS = 272;
constexpr int POOL_TILE = 48 * POOL_RS;
template <int W>
__device__ __forceinline__ void pool_window_lds(const bf16_t* Zg, int tok0, int lane, LAS unsigned char* tile, bf16x8 (&Bf)[8]) {
    constexpr int NR = 32 + W - 1, NI = (NR + 3) / 4;
    const int rr = lane >> 4, cc = lane & 15;
    u32x4 st[NI];
#pragma unroll
    for (int i = 0; i < NI; ++i) { const int r = 4 * i + rr; int tk = tok0 - (W - 1) + r; tk = tk < 0 ? 0 : tk; tk = tk > NT - 1 ? NT - 1 : tk;
        st[i] = *(const u32x4*)(Zg + (size_t)tk * ZP + cc * 8); }
#pragma unroll
    for (int i = 0; i < NI; ++i) { const int r = 4 * i + rr; if (r < NR) *(LAS u32x4*)(tile + r * POOL_RS + cc * 16) = st[i]; }
    LDS_WAIT(); asm volatile("" ::: "memory");
    const int l31 = lane & 31, hh = lane >> 5, t = (tok0 + l31) % SEQ;
    const int cntw = (t + 1) < W ? (t + 1) : W; const float inv = 1.0f / (float)cntw;
    const LAS unsigned char* base = tile + (l31 + W - 1) * POOL_RS + hh * 16;
#pragma unroll
    for (int s2 = 0; s2 < 8; ++s2) {
        u32x4 a[W];
#pragma unroll
        for (int j = 0; j < W; ++j) a[j] = *(const LAS u32x4*)(base - j * POOL_RS + 32 * s2);
        float acc[8];
#pragma unroll
        for (int i = 0; i < 8; ++i) acc[i] = 0.f;
#pragma unroll
        for (int j = 0; j < W; ++j) { const float m = j < cntw ? 1.f : 0.f;
            acc[0] += m * bf_lo(a[j].x); acc[1] += m * bf_hi(a[j].x); acc[2] += m * bf_lo(a[j].y); acc[3] += m * bf_hi(a[j].y);
            acc[4] += m * bf_lo(a[j].z); acc[5] += m * bf_hi(a[j].z); acc[6] += m * bf_lo(a[j].w); acc[7] += m * bf_hi(a[j].w); }
        const float s0 = bf_lo(a[0].x), s1 = bf_hi(a[0].x), s2f = bf_lo(a[0].y), s3 = bf_hi(a[0].y), s4 = bf_lo(a[0].z), s5 = bf_hi(a[0].z), s6 = bf_lo(a[0].w), s7 = bf_hi(a[0].w);
        u32x4 pk; pk.x = cvt_pk_bf16(acc[0] * inv - s0, acc[1] * inv - s1); pk.y = cvt_pk_bf16(acc[2] * inv - s2f, acc[3] * inv - s3);
        pk.z = cvt_pk_bf16(acc[4] * inv - s4, acc[5] * inv - s5); pk.w = cvt_pk_bf16(acc[6] * inv - s6, acc[7] * inv - s7);
        Bf[s2] = __builtin_bit_cast(bf16x8, pk);
    }
}
__device__ __forceinline__ void pool_mfma(Frame& F, const Args& AR, int li) {
    const bf16_t* Z = (const bf16_t*)(F_WS + WS_Z); bf16_t* YM = (bf16_t*)(F_WS + WS_YM);
    const bf16_t* PWT = (const bf16_t*)(F_WS + WS_PWT) + (size_t)li * 4 * 16384; const float* PS = KIN(7) + (size_t)li * 512;
    const int lane = F_LANE, l31 = lane & 31, hh = lane >> 5;
    const int NJOB = 2048, W0 = F_BID * NWAVES + F_WAVE, NW = F_G * NWAVES;
    for (int job = W0; job < NJOB; job += NW) {
        const int g = job & 3, tile = job >> 2;
        const int tok = tile * 32 + l31, t = tok % SEQ;
        bf16x8 Bf[8];
        const bf16_t* Zg = Z + g * 128; LAS unsigned char* ptile = F.lds + F_WAVE * POOL_TILE;
        switch (__builtin_amdgcn_readfirstlane(g)) {
            case 0: pool_window_lds<2>(Zg, tile * 32, lane, ptile, Bf); break;
            case 1: pool_window_lds<4>(Zg, tile * 32, lane, ptile, Bf); break;
            case 2: pool_window_lds<8>(Zg, tile * 32, lane, ptile, Bf); break;
            default: pool_window_lds<16>(Zg, tile * 32, lane, ptile, Bf); break;
        }
#pragma unroll
        for (int dt = 0; dt < 4; ++dt) {
            f32x16 C;
#pragma unroll
            for (int i = 0; i < 16; ++i) C[i] = 0.f;
            const bf16_t* arow = PWT + (size_t)g * 16384 + (size_t)(32 * dt + l31) * 128 + 8 * hh;
#pragma unroll
            for (int s2 = 0; s2 < 8; ++s2) { const bf16x8 Af = *(const bf16x8*)(arow + 16 * s2); C = __builtin_amdgcn_mfma_f32_32x32x16_bf16(Af, Bf[s2], C, 0, 0, 0); }
            bf16_t* op = YM + (size_t)tok * DM + g * 128 + 32 * dt + 4 * hh; const float* ps = PS + g * 128 + 32 * dt + 4 * hh;
#pragma unroll
            for (int k4 = 0; k4 < 4; ++k4) { const f32x4 sc = *(const f32x4*)(ps + 8 * k4); u32x2 wv;
                wv.x = cvt_pk_bf16(C[4 * k4 + 0] * sc.x, C[4 * k4 + 1] * sc.y); wv.y = cvt_pk_bf16(C[4 * k4 + 2] * sc.z, C[4 * k4 + 3] * sc.w);
                *(u32x2*)(op + 8 * k4) = wv; }
        }
    }
}
typedef float f32x4v __attribute__((ext_vector_type(4)));
__device__ __forceinline__ void router_mfma(Frame& F, const Args& AR, int layer) {
    const bf16_t* WRH = (const bf16_t*)(F_WS + WS_WRT) + (size_t)layer * 80 * 1024; const bf16_t* WRL = WRH + NL * 80 * 1024; const bf16_t* XBp = (const bf16_t*)(F_WS + WS_XB);
    const float* GB = KIN(14) + layer * 8; const float* EB = KIN(16) + layer * 64; const float* gn = KIN(2) + (size_t)layer * DM;
    i32x4* list = (i32x4*)(F_WS + WS_LIST); i32x4* tinfo = (i32x4*)(F_WS + WS_TOKINFO);
    unsigned* cnt = F_CTL + CW_CNT + layer * NE * 64;
    LAS float* part = (LAS float*)(F.lds);
    LAS float* lg = (LAS float*)(F.lds + 90112);
    LAS float* rs = (LAS float*)(F.lds + 90112 + 20992);
    LAS unsigned* lcnt = (LAS unsigned*)(F.lds + 90112 + 20992 + 256);
    const int lane = F_LANE, a_tok = lane & 15, kq = lane >> 4, w = F_WAVE;
    for (int unit = F_BID; unit < NT / 64; unit += F_G) {
        const int tokb = unit * 64;
        f32x4 acc[4][5]; float ss[4];
#pragma unroll
        for (int t = 0; t < 4; ++t) { ss[t] = 0.f;
#pragma unroll
            for (int nt = 0; nt < 5; ++nt) acc[t][nt] = (f32x4){0.f, 0.f, 0.f, 0.f}; }
        const unsigned woff = (unsigned)((a_tok * 1024 + w * 128 + 8 * kq) * 2), xoff = (unsigned)(((tokb + a_tok) * DM + w * 128 + 8 * kq) * 2);
        const GAS char* whb[5]; const GAS char* wlb[5]; const GAS char* xb = (const GAS char*)XBp;
#pragma unroll
        for (int nt = 0; nt < 5; ++nt) { whb[nt] = (const GAS char*)WRH + nt * 32768; wlb[nt] = (const GAS char*)WRL + nt * 32768; asm volatile("" : "+s"(whb[nt]), "+s"(wlb[nt])); }
        bf16x8 wh[2][5], wl[2][5]; u32x4 xv[2][4];
#define R_LOAD(b, j) { _Pragma("unroll") for (int nt = 0; nt < 5; ++nt) { wh[b][nt] = *(const GAS bf16x8*)(whb[nt] + 64 * (j) + woff); wl[b][nt] = *(const GAS bf16x8*)(wlb[nt] + 64 * (j) + woff); } \
                       _Pragma("unroll") for (int t = 0; t < 4; ++t) xv[b][t] = *(const GAS u32x4*)(xb + (t * 16 * DM * 2 + 64 * (j)) + xoff); }
#define R_COMP(b) { _Pragma("unroll") for (int t = 0; t < 4; ++t) { const u32x4 xr4 = xv[b][t]; \
                { const float x0 = bf_lo(xr4.x), x1 = bf_hi(xr4.x), x2 = bf_lo(xr4.y), x3 = bf_hi(xr4.y), x4 = bf_lo(xr4.z), x5 = bf_hi(xr4.z), x6 = bf_lo(xr4.w), x7 = bf_hi(xr4.w); \
                  ss[t] += ((x0 * x0 + x1 * x1) + (x2 * x2 + x3 * x3)) + ((x4 * x4 + x5 * x5) + (x6 * x6 + x7 * x7)); } \
                const bf16x8 xa = __builtin_bit_cast(bf16x8, xr4); \
                _Pragma("unroll") for (int nt = 0; nt < 5; ++nt) { acc[t][nt] = __builtin_amdgcn_mfma_f32_16x16x32_bf16(xa, wh[b][nt], acc[t][nt], 0, 0, 0); acc[t][nt] = __builtin_amdgcn_mfma_f32_16x16x32_bf16(xa, wl[b][nt], acc[t][nt], 0, 0, 0); } } }
        R_LOAD(0, 0); R_LOAD(1, 1); __builtin_amdgcn_sched_barrier(0);
        R_COMP(0); __builtin_amdgcn_sched_barrier(0); R_LOAD(0, 2); __builtin_amdgcn_sched_barrier(0);
        R_COMP(1); __builtin_amdgcn_sched_barrier(0); R_LOAD(1, 3); __builtin_amdgcn_sched_barrier(0);
        R_COMP(0); R_COMP(1);
#undef R_LOAD
#undef R_COMP
#pragma unroll
        for (int t = 0; t < 4; ++t) { ss[t] += __shfl_xor(ss[t], 16); ss[t] += __shfl_xor(ss[t], 32); }
#pragma unroll
        for (int half = 4; half >= 1; half >>= 1) {
            __syncthreads();
            if (w >= half && w < 2 * half) { LAS f32x4* p = (LAS f32x4*)part + (size_t)(w - half) * (21 * 64) + lane;
#pragma unroll
                for (int t = 0; t < 4; ++t) {
#pragma unroll
                    for (int nt = 0; nt < 5; ++nt) p[(t * 5 + nt) * 64] = acc[t][nt]; }
                p[20 * 64] = (f32x4){ss[0], ss[1], ss[2], ss[3]}; }
            __syncthreads();
            if (w < half) { const LAS f32x4* p = (const LAS f32x4*)part + (size_t)w * (21 * 64) + lane;
#pragma unroll
                for (int t = 0; t < 4; ++t) {
#pragma unroll
                    for (int nt = 0; nt < 5; ++nt) acc[t][nt] += p[(t * 5 + nt) * 64]; }
                const f32x4 s4 = p[20 * 64]; ss[0] += s4.x; ss[1] += s4.y; ss[2] += s4.z; ss[3] += s4.w; }
        }
        if (w == 0) {
            const int l2 = F_LANE, a2 = l2 & 15, k2 = l2 >> 4;
#pragma unroll
            for (int t = 0; t < 4; ++t) { const float rstd = 1.0f / sqrtf(ss[t] * (1.f / DM) + EPS); if (k2 == 0) rs[t * 16 + a2] = rstd; }
            LDS_WAIT(); asm volatile("" ::: "memory");
            LAS float* lgb = lg + k2 * 324 + a2; const LAS float* rsb = rs + 4 * k2;
#pragma unroll
            for (int nt = 0; nt < 5; ++nt) { const int n = 16 * nt + a2; const float bias = n < 8 ? GB[n] : (n < 72 ? EB[n - 8] : 0.f);
#pragma unroll
                for (int t = 0; t < 4; ++t) {
#pragma unroll
                    for (int rg = 0; rg < 4; ++rg) lgb[(t * 16 + rg) * 81 + 16 * nt] = acc[t][nt][rg] * rsb[t * 16 + rg] + bias; } }
        }
        __syncthreads();
        int x1 = 0, x2 = 0; unsigned r1 = 0, r2 = 0; float g1 = 0.f, g2 = 0.f;
        if (F_TID < 64) lcnt[F_TID] = 0u;
        __syncthreads();
        if (F_TID < 64) {
            const LAS float* L = lg + F_TID * 81;
            float m = L[0]; int gi = 0;
            for (int i = 1; i < 8; ++i) if (L[i] > m) { m = L[i]; gi = i; }
            float s = 0.f; for (int i = 0; i < 8; ++i) s += __expf(L[i] - m);
            const float gp = 1.0f / s;
            const LAS float* E = L + 8 + gi * 8;
            float t1 = E[0]; int i1 = 0;
            for (int i = 1; i < 8; ++i) if (E[i] > t1) { t1 = E[i]; i1 = i; }
            float t2 = -INFINITY; int i2 = 0;
            for (int i = 0; i < 8; ++i) if (i != i1 && E[i] > t2) { t2 = E[i]; i2 = i; }
            const float e2 = __expf(t2 - t1); const float p1 = 1.0f / (1.0f + e2), p2 = e2 / (1.0f + e2);
            x1 = gi * 8 + i1; x2 = gi * 8 + i2; g1 = gp * p1; g2 = gp * p2;
            r1 = __hip_atomic_fetch_add(lcnt + x1, 1u, __ATOMIC_RELAXED, __HIP_MEMORY_SCOPE_WORKGROUP);
            r2 = __hip_atomic_fetch_add(lcnt + x2, 1u, __ATOMIC_RELAXED, __HIP_MEMORY_SCOPE_WORKGROUP);
        }
        __syncthreads();
        if (F_TID < 64) { const unsigned c = lcnt[F_TID]; unsigned base = 0u;
            if (c) base = __hip_atomic_fetch_add(cnt + F_TID * 64, c, __ATOMIC_RELAXED, __HIP_MEMORY_SCOPE_AGENT);
            lcnt[F_TID] = base; }
        __syncthreads();
        if (F_TID < 64) {
            const int tok = tokb + F_TID; const int pos1 = (int)(lcnt[x1] + r1), pos2 = (int)(lcnt[x2] + r2);
            const int rsi = __float_as_int(rs[F_TID]);
            list[(size_t)x1 * NT + pos1] = (i32x4){tok, __float_as_int(g1), rsi, 0};
            list[(size_t)x2 * NT + pos2] = (i32x4){tok, __float_as_int(g2), rsi, 0};
            tinfo[tok] = (i32x4){x1, pos1, x2, pos2};
        }
    }
    __syncthreads();
}
__device__ __forceinline__ void combine_phase(Frame& F, const Args& AR, int layer, bool have_seg) {
    const MoeTabs T = moe_tabs(F);
    if (!have_seg) moe_build_seg(F, AR, T, layer);
    const bf16_t* Y = (const bf16_t*)(F_WS + WS_YMOE); const i32x4* tinfo = (const i32x4*)(F_WS + WS_TOKINFO);
    const bool lastl = (layer == NL - 1);
    const float* gn = lastl ? KIN(3) : KIN(1) + (size_t)(layer + 1) * DM;
    const int gw = F_BID * NWAVES + F_WAVE, NGW = F_G * NWAVES;
    for (int m0 = gw; m0 < NT; m0 += 2 * NGW) {
        const int m1 = m0 + NGW; const bool two = m1 < NT;
        const i32x4 ti0 = tinfo[m0]; i32x4 ti1 = ti0; if (two) ti1 = tinfo[m1];
        u32x2 ya[2][4], yb[2][4], xv[2][4];
#pragma unroll
        for (int q = 0; q < 2; ++q) {
            const i32x4 ti = q ? ti1 : ti0; const int m = q ? (two ? m1 : m0) : m0;
            const int ra = T.seg[ti.x] + ti.y, rb = T.seg[ti.z] + ti.w;
            const u32x2* xi = (const u32x2*)((const bf16_t*)(F_WS + WS_XB) + (size_t)m * DM) + F_LANE; const u32x2* pa = (const u32x2*)(Y + (size_t)ra * DM) + F_LANE; const u32x2* pb = (const u32x2*)(Y + (size_t)rb * DM) + F_LANE;
#pragma unroll
            for (int j = 0; j < 4; ++j) { ya[q][j] = pa[64 * j]; yb[q][j] = pb[64 * j]; xv[q][j] = xi[64 * j]; }
        }
#pragma unroll
        for (int q = 0; q < 2; ++q) {
            if (q == 1 && !two) break;
            const int m = q ? m1 : m0;
            u32x2* xr = (u32x2*)((bf16_t*)(F_WS + WS_X16) + (size_t)m * DM) + F_LANE;
            f32x4 v[4];
#pragma unroll
            for (int j = 0; j < 4; ++j) { const u32x2 a = ya[q][j], b = yb[q][j]; const u32x2 xx = xv[q][j]; f32x4 x = (f32x4){bf_lo(xx.x), bf_hi(xx.x), bf_lo(xx.y), bf_hi(xx.y)};
#ifndef DBG_NO_MOE
                x.x += bf_lo(a.x) + bf_lo(b.x); x.y += bf_hi(a.x) + bf_hi(b.x); x.z += bf_lo(a.y) + bf_lo(b.y); x.w += bf_hi(a.y) + bf_hi(b.y);
#endif
                v[j] = x; }
            if (lastl) norm_row(v, gn, F_LANE, nullptr, F_X + (size_t)m * DM);
            else {
#pragma unroll
                for (int j = 0; j < 4; ++j) { u32x2 w; w.x = cvt_pk_bf16(v[j].x, v[j].y); w.y = cvt_pk_bf16(v[j].z, v[j].w); xr[64 * j] = w; }
                row_rstd(v, F_LANE, (float*)(F_WS + WS_RSTD) + m);
            }
        }
    }
}

constexpr int NPH = 1 + NL * 7;
#ifndef PH_MASK
#define PH_MASK 0xFF
#endif
#define EN(b) (((PH_MASK) >> (b)) & 1)
#ifndef REP_MASK
#define REP_MASK 0
#endif
#define REPS(b) (1 + (((REP_MASK) >> (b)) & 1))
#define IN(k) (AR.ph_lo <= (k) && (k) < AR.ph_hi)
#define SEAM(k) do { if (IN((k) + 1)) { XcdBarrier _b; _b.bar = F_CTL + CW_BAR; _b.x = xb_xcc_id(); _b.st = (volatile LAS unsigned*)(F.lds + MISC_OFF + MO_BAR); xcd_barrier(_b); } } while (0)

template <int layer>
__device__ __forceinline__ void layer_phases(Frame& F, const Args& AR) {
    constexpr int pb = 1 + layer * 7; constexpr int li = layer >> 1; constexpr bool odd = (layer & 1) != 0;
    if (EN(0) && IN(pb + 0)) {
        pg8::PlainSched S; S.init(F_WS + WS_X16, F_WS + WS_WIN + (size_t)layer * 2048 * DM * 2, NT, 2048, DM, F_G, F_BID);
        pg8::EpiZ<odd> E{(bf16_t*)(F_WS + WS_Z), (float*)(F_WS + WS_VSTAT), (const float*)(F_WS + WS_RSTD)}; for (int rep = 0; rep < REPS(0); ++rep) pg8::gemm_phase<pg8::EpiZ<odd>, pg8::PlainSched, true>(F.lds, DM, S, E);
        SEAM(pb + 0);
    }
    if (EN(1) && IN(pb + 1)) {
        for (int rep = 0; rep < REPS(1); ++rep) { if (!odd) { for (int r2 = 0; r2 < REPS(8); ++r2) attn_mfma(F, AR); for (int r2 = 0; r2 < REPS(9); ++r2) pool_mfma(F, AR, li); } else { for (int r2 = 0; r2 < REPS(10); ++r2) sgu_mfma(F, AR, li); } }
        SEAM(pb + 1);
    }
    if (EN(2) && IN(pb + 2)) {
        pg8::PlainSched S; S.init(F_WS + WS_YM, F_WS + WS_WOUT + (size_t)layer * DM * DM * 2, NT, DM, DM, F_G, F_BID);
        pg8::EpiResid E{(const bf16_t*)(F_WS + WS_X16), (bf16_t*)(F_WS + WS_XB)}; for (int rep = 0; rep < REPS(2); ++rep) pg8::gemm_phase<pg8::EpiResid, pg8::PlainSched, false>(F.lds, DM, S, E);
        SEAM(pb + 2);
    }
    if (EN(3) && IN(pb + 3)) { router_mfma(F, AR, layer); SEAM(pb + 3); }
    if (EN(4) && IN(pb + 4)) {
        const MoeTabs T = moe_tabs(F);
        moe_build_seg(F, AR, T, layer);
        const int nfull = __builtin_amdgcn_readfirstlane(T.fst[NE]), total = nfull + __builtin_amdgcn_readfirstlane(T.hst[NE]);
        const bool fusedM = EN(5) && IN(pb + 5) && moe_fusable(nfull, total, F_G);
        for (int rep = 0; rep < REPS(4); ++rep)
        for (int base = 0; base < total; base += MAXU * F_G) {
            int nfw; const int nu = moe_build_units(F, AR, T, layer, base, true, nfull, total, false, nfw);
            pg4::gemm4_phase<0, 32, DE>(F.lds, T.tab, T.toks, T.rstd, (const char*)(F_WS + WS_XB), KIN(17), KIN(18), KIN(2) + (size_t)layer * DM, (bf16_t*)(F_WS + WS_HMOE), layer, nu);
            __syncthreads();
            if (fusedM && rep == 0) moe_publish(F, AR, T, layer, nu);
        }
        if (!fusedM) SEAM(pb + 4);
    }
    if (EN(5) && IN(pb + 5)) {
        const MoeTabs T = moe_tabs(F);
        const bool have = EN(4) && IN(pb + 4);
        if (!have) moe_build_seg(F, AR, T, layer);
        const int nfull = __builtin_amdgcn_readfirstlane(T.fst[NE]), total = nfull + __builtin_amdgcn_readfirstlane(T.hst[NE]);
        const bool fusedM = have && moe_fusable(nfull, total, F_G);
        const bool reuse = have && !fusedM && total <= MAXU * F_G;
        for (int rep = 0; rep < REPS(5); ++rep)
        for (int base = 0; base < total; base += MAXU * F_G) {
            int nfw; const int nu = moe_build_units(F, AR, T, layer, base, !reuse && !fusedM, nfull, total, fusedM, nfw);
            if (!fusedM) nfw = nu;
#pragma nounroll
            for (int part = 0; part < 2; ++part) { const int s0 = part ? nfw : 0, s1 = part ? nu : nfw;
                if (s1 > s0) {
                    if (fusedM && part) { int dummy; (void)moe_build_units(F, AR, T, layer, base, true, nfull, total, true, dummy, nfw); }
                    if (fusedM) moe_wait(F, AR, T, layer, s0, s1);
                    pg4::gemm4_phase<1, 16, DM>(F.lds, T.tab + s0 * 8, T.toks + s0 * 256, T.gates + s0 * 256, (const char*)(F_WS + WS_HMOE), KIN(19), KIN(19), nullptr, (bf16_t*)(F_WS + WS_YMOE), layer, s1 - s0);
                    __syncthreads(); } }
        }
        SEAM(pb + 5);
    }
        if (EN(6) && IN(pb + 6)) { for (int rep = 0; rep < REPS(6); ++rep) combine_phase(F, AR, layer, (EN(4) && IN(pb + 4)) || (EN(5) && IN(pb + 5)));
    if (layer + 1 < NL) SEAM(pb + 6); }
}

__global__ void __launch_bounds__(NTHR, 2) fwd_kernel(Args AR) {
    extern __shared__ __attribute__((aligned(16))) unsigned char lds_raw[];
    Frame F;
    F.lds = (LAS unsigned char*)lds_raw;
    for (int u = F_TID; u < (LDS_BYTES - MISC_OFF) / 4; u += NTHR) ((LAS unsigned*)(F.lds + MISC_OFF))[u] = 0u;
    __syncthreads();
    if (AR.ph_hi - AR.ph_lo > 1) (void)xcd_barrier_post(F_CTL + CW_BAR, (volatile LAS unsigned*)(F.lds + MISC_OFF + MO_BAR));

    if (EN(7) && IN(0)) { for (int rep = 0; rep < REPS(7); ++rep) p0_prologue(F, AR); SEAM(0); }
    layer_phases<0>(F, AR);
    layer_phases<1>(F, AR);
    layer_phases<2>(F, AR);
    layer_phases<3>(F, AR);
}
#undef IN
#undef SEAM

extern "C" void kernel_launch(void* const* d_in, const int* in_sizes, int n_in, void* d_out, int out_size, void* d_ws, size_t ws_size, hipStream_t stream) {
    static int grid = 0;
    if (grid == 0) {
        if (n_in != 20 || out_size != NT * DM || ws_size < WS_END) { fprintf(stderr, "kernel_launch: unexpected problem (n_in %d out %d ws %zu)\n", n_in, out_size, ws_size); grid = -1; return; }
        int dev = 0, cus = 0, per_cu = 0;
        if (hipGetDevice(&dev) != hipSuccess || hipDeviceGetAttribute(&cus, hipDeviceAttributeMultiprocessorCount, dev) != hipSuccess) { grid = -1; return; }
        if (hipFuncSetAttribute((const void*)fwd_kernel, hipFuncAttributeMaxDynamicSharedMemorySize, LDS_BYTES) != hipSuccess) { fprintf(stderr, "kernel_launch: hipFuncSetAttribute failed\n"); grid = -1; return; }
        if (hipOccupancyMaxActiveBlocksPerMultiprocessor(&per_cu, (const void*)fwd_kernel, NTHR, LDS_BYTES) != hipSuccess || per_cu < 1) fprintf(stderr, "kernel_launch: occupancy query says %d\n", per_cu);
        (void)hipGetLastError();
        grid = cus;
    }
    if (grid < 0) return;
    (void)hipMemsetAsync((char*)d_ws + WS_CTL, 0, CTL_ZERO_BYTES, stream);
    Args a{};
    for (int i = 0; i < 20; ++i) a.in[i] = (const float*)d_in[i];
    a.out = (float*)d_out; a.ws = (unsigned char*)d_ws;
#if MK_ONE_LAUNCH
    a.ph_lo = 0; a.ph_hi = NPH;
    hipLaunchKernelGGL(fwd_kernel, dim3(grid), dim3(NTHR), LDS_BYTES, stream, a);
#else
    for (int p = 0; p < NPH; ++p) { a.ph_lo = p; a.ph_hi = p + 1; hipLaunchKernelGGL(fwd_kernel, dim3(grid), dim3(NTHR), LDS_BYTES, stream, a); }
#endif
}
```

```cpp
#include <hip/hip_runtime.h>
#include <cstdio>
#include <cstdint>

#ifndef MK_ONE_LAUNCH
#define MK_ONE_LAUNCH 1
#endif

#define LAS __attribute__((address_space(3)))
#define GAS __attribute__((address_space(1)))
typedef unsigned short bf16_t;
typedef short bf16x8 __attribute__((ext_vector_type(8)));
typedef float f32x4 __attribute__((ext_vector_type(4)));
typedef float f32x2 __attribute__((ext_vector_type(2)));
typedef unsigned u32x4 __attribute__((ext_vector_type(4)));
typedef unsigned u32x2 __attribute__((ext_vector_type(2)));
typedef int i32x4 __attribute__((ext_vector_type(4)));
typedef int i32x2 __attribute__((ext_vector_type(2)));

constexpr int NT = 16384, DM = 1024, SEQ = 2048, NL = 4, NE = 64, DE = 512;
constexpr int NWAVES = 8, NTHR = 512;
constexpr float EPS = 1e-6f;
constexpr int ZP = 2048 + 64;
constexpr int ZERO_ROW = NT;
constexpr int NR_ALLOC = 42496;

constexpr size_t MiB = 1u << 20;
constexpr size_t WS_CTL = 0, CTL_ZERO_BYTES = 1 * MiB;
constexpr size_t WS_WSB = 1 * MiB;
constexpr size_t WS_PWT = 1 * MiB + 512 * 1024;
constexpr size_t WS_WIN = 2 * MiB;
constexpr size_t WS_WOUT = 18 * MiB;
constexpr size_t WS_Z = 292 * MiB;
constexpr size_t WS_YM = 123 * MiB;
constexpr size_t WS_VSTAT = 155 * MiB;
constexpr size_t WS_LIST = 400 * MiB;
constexpr size_t WS_TOKINFO = 165 * MiB;
constexpr size_t WS_RSTD = 165 * MiB + 512 * 1024;
constexpr size_t WS_HMOE = 166 * MiB;
constexpr size_t WS_YMOE = 208 * MiB;
constexpr size_t WS_XB = 420 * MiB;
constexpr size_t WS_X16 = 1092 * MiB;
constexpr size_t WS_WRT = 1124 * MiB;
constexpr size_t WS_END = 1126 * MiB;
constexpr int CW_TMO = 0, CW_BAR = 4096, CW_CNT = 8192  , CW_DBG = 40960, CW_BLK = 65536  ;

constexpr int RING_BYTES = 147456;
constexpr int MISC_OFF = RING_BYTES;
constexpr int LDS_BYTES = 161792;
constexpr int MO_BAR = 0;
constexpr int MO_CNT = 64;
constexpr int MO_SEG = MO_CNT + 256;
constexpr int MO_FST = MO_SEG + 272;
constexpr int MO_HST = MO_FST + 272;
constexpr int MAXU = 4;
constexpr int MO_TAB = MO_HST + 272;
constexpr int MO_NMY = MO_TAB + MAXU * 32;
constexpr int MO_TOKS = 2048;
constexpr int MO_GATES = 2048 + 4096;
static_assert(MO_NMY + 4 * MAXU <= MO_TOKS, "misc map");
constexpr int MO_RSTD = MO_GATES + 4096;
static_assert(MISC_OFF + MO_RSTD + MAXU * 1024 <= LDS_BYTES, "misc map 2");

__device__ __forceinline__ unsigned cvt_pk_bf16(float lo, float hi) { unsigned r; asm volatile("v_cvt_pk_bf16_f32 %0, %1, %2" : "=v"(r) : "v"(lo), "v"(hi)); return r; }
__device__ __forceinline__ float bf_lo(unsigned u) { return __builtin_bit_cast(float, u << 16); }
__device__ __forceinline__ float bf_hi(unsigned u) { return __builtin_bit_cast(float, u & 0xffff0000u); }
__device__ __forceinline__ float wave_sum(float v) {
#pragma unroll
    for (int o = 1; o < 64; o <<= 1) v += __shfl_xor(v, o);
    return v;
}
__device__ __forceinline__ float wave_max(float v) {
#pragma unroll
    for (int o = 1; o < 64; o <<= 1) v = fmaxf(v, __shfl_xor(v, o));
    return v;
}
__device__ __forceinline__ float gelu_tanh(float x) {
    const float u = 0.7978845608028654f * (x + 0.044715f * x * x * x);
    const float e = __builtin_amdgcn_exp2f(-2.0f * 1.4426950408889634f * u);
    return x * __builtin_amdgcn_rcpf(1.0f + e);
}
__device__ __forceinline__ float silu_f(float x) {
    const float e = __builtin_amdgcn_exp2f(-1.4426950408889634f * x);
    return x * __builtin_amdgcn_rcpf(1.0f + e);
}
__device__ __forceinline__ int opaque_tid() { int t = (int)threadIdx.x; asm volatile("" : "+v"(t)); return t; }
#define LDS_WAIT() asm volatile("s_waitcnt lgkmcnt(0)" ::: "memory")
#define VM_WAIT() asm volatile("s_waitcnt vmcnt(0)" ::: "memory")

#define XB_TMO      128
#define XB_XCNT(j)  (256  + 64 * (j))
#define XB_XSUB(j)  (1280 + 64 * (j))
#define XB_XGEN(j)  (2304 + 64 * (j))
#define XB_TOP      3328
#define XB_TOPGEN   3392
#define XCD_BAR_WORDS 3456
#define XB_SPIN_CAP (1u << 20)

__device__ __forceinline__ unsigned xb_ld(unsigned* p)              { return __hip_atomic_load(p, __ATOMIC_RELAXED, __HIP_MEMORY_SCOPE_AGENT); }
__device__ __forceinline__ unsigned xb_add(unsigned* p, unsigned v) { return __hip_atomic_fetch_add(p, v, __ATOMIC_RELAXED, __HIP_MEMORY_SCOPE_AGENT); }
__device__ __forceinline__ unsigned xb_xcc_id() { return (unsigned)__builtin_amdgcn_s_getreg((3 << 11) | 20) & 0xFu; }
#define XB_SPIN(cond, bar) do { unsigned _sp = 0; while (cond) { __builtin_amdgcn_s_sleep(1); \
    if ((++_sp & 255u) == 0u) { if (xb_ld(&(bar)[XB_TMO])) break; if (_sp > XB_SPIN_CAP) { atomicAdd(&(bar)[XB_TMO], 1u); break; } } } } while (0)

struct XcdBarrier { unsigned* bar; unsigned x; volatile LAS unsigned* st; };

__device__ __forceinline__ XcdBarrier xcd_barrier_post(unsigned* bar, volatile LAS unsigned* st) {
    XcdBarrier b; b.bar = bar; b.x = xb_xcc_id(); b.st = st;
    if (threadIdx.x == 0) (void)xb_add(&bar[XB_XCNT(b.x)], 1u);
    return b;
}
__device__ __forceinline__ void xcd_barrier_complete(unsigned* bar, unsigned x, unsigned& nloc, unsigned& nx) {
    const unsigned G = gridDim.x * gridDim.y * gridDim.z;
    unsigned sum, cnt, mine, sp = 0u;
    for (;;) {
        sum = 0u; cnt = 0u; mine = 0u;
#pragma unroll
        for (unsigned j = 0; j < 16; ++j) { const unsigned c = xb_ld(&bar[XB_XCNT(j)]); sum += c; cnt += (c > 0u) ? 1u : 0u; mine = (j == x) ? c : mine; }
        if (sum == G) break;
        __builtin_amdgcn_s_sleep(1);
        if ((++sp & 255u) == 0u) { if (xb_ld(&bar[XB_TMO])) break; if (sp > XB_SPIN_CAP) { atomicAdd(&bar[XB_TMO], 1u); break; } }
    }
    nloc = mine > 0u ? mine : 1u; nx = cnt > 0u ? cnt : 1u;
}
__device__ __forceinline__ void xcd_barrier(const XcdBarrier& b) {
    asm volatile("s_waitcnt vmcnt(0)" ::: "memory");
    __syncthreads();
    if (threadIdx.x == 0) {
        unsigned* bar = b.bar;
        __builtin_amdgcn_s_waitcnt(0);
        unsigned nloc = b.st[0], nx = b.st[1];
        if (nloc == 0u) { xcd_barrier_complete(bar, b.x, nloc, nx); b.st[0] = nloc; b.st[1] = nx; }
        const unsigned old = xb_add(&bar[XB_XSUB(b.x)], 1u);
        const unsigned gen = old / nloc;
        if (old + 1u == (gen + 1u) * nloc) {
            __builtin_amdgcn_fence(__ATOMIC_RELEASE, "agent");
            asm volatile("s_waitcnt vmcnt(0)" ::: "memory");
            const unsigned og = xb_add(&bar[XB_TOP], 1u);
            const unsigned tg = og / nx;
            if (og + 1u == (tg + 1u) * nx) xb_add(&bar[XB_TOPGEN], 1u);
            else XB_SPIN(xb_ld(&bar[XB_TOPGEN]) == tg, bar);
            __builtin_amdgcn_fence(__ATOMIC_ACQUIRE, "agent");
            xb_add(&bar[XB_XGEN(b.x)], 1u);
            asm volatile("s_waitcnt vmcnt(0)" ::: "memory");
        } else {
            XB_SPIN(xb_ld(&bar[XB_XGEN(b.x)]) == gen, bar);
            __builtin_amdgcn_fence(__ATOMIC_ACQUIRE, "agent");
            asm volatile("s_waitcnt vmcnt(0)" ::: "memory");
        }
    }
    __syncthreads();
}

namespace pg8 {
constexpr int BM = 256, BK = 64, HALF = 128, HTB = HALF * BK * 2, STAGE_BYTES = 8 * HTB, NXCD = 8, WGM = 8;
__host__ __device__ __forceinline__ int lds_byte(int r, int c) { const int st = (r >> 4) * 2 + (c >> 5), rr = r & 15, cc = c & 31, ob = rr * 64 + cc * 2; return st * 1024 + (ob ^ (((ob >> 9) & 1) << 5)); }
__host__ __device__ __forceinline__ void stage_rc(int b, int& R, int& C) { const int st = b / 1024, sb = b % 1024, swz = sb ^ (((sb >> 9) & 1) << 5); R = (st >> 1) * 16 + swz / 64; C = (st & 1) * 32 + (swz % 64) / 2; }
__host__ __device__ __forceinline__ int perm32(int rho) { const int n = rho >> 4, i = rho & 15; return 8 * (i >> 2) + 4 * n + (i & 3); }

struct Unit { const char* A; const char* B; int rowbase; int pn; int nvalid; int slot; };

struct PlainSched {
    static constexpr bool ALWAYS_FULL = true;
    const char* A; const char* Bt; int K; int nM, nN, nwg, G, c;
    __device__ __forceinline__ void init(const void* A_, const void* Bt_, int M, int N, int K_, int G_, int c_) { A = (const char*)A_; Bt = (const char*)Bt_; K = K_; nM = M / BM; nN = N / BM; nwg = nM * nN; G = G_; c = c_; }
    __device__ __forceinline__ bool next(int i, Unit& u) const {
        const long L = (long)i * G + c; if (L >= nwg) return false;
        int wgid = (int)L; { const int q = nwg / NXCD, r = nwg % NXCD, xcd = wgid % NXCD, off = wgid / NXCD; wgid = (xcd < r ? xcd * (q + 1) : r * (q + 1) + (xcd - r) * q) + off; }
        const int nig = WGM * nN, gid = wgid / nig, fm = gid * WGM, gsz = (nM - fm) < WGM ? (nM - fm) : WGM;
        const int pm = fm + ((wgid % nig) % gsz), pn = (wgid % nig) / gsz;
        u.A = A + (size_t)pm * BM * K * 2; u.B = Bt + (size_t)pn * BM * K * 2; u.rowbase = pm * BM; u.pn = pn; u.nvalid = 256; u.slot = 0; return true;
    }
    __device__ __forceinline__ void aoff(const Unit& u, const int (&R)[2], const int (&C)[2], unsigned (&vo)[2][2]) const {
#pragma unroll
        for (int h = 0; h < 2; ++h)
#pragma unroll
            for (int i = 0; i < 2; ++i) vo[h][i] = (unsigned)(((h * HALF + R[i]) * K + C[i]) * 2);
    }
};

template <class Epi, class Sched, bool ALIGN_EPI>
__device__ __forceinline__ void gemm_phase(LAS unsigned char* lds, const int K, const Sched& S, const Epi& E) {
    const int tid = opaque_tid(), wid = __builtin_amdgcn_readfirstlane(tid >> 6), lane = tid & 63, wr = wid >> 2, wc = wid & 3, fr = lane & 15, fq = lane >> 4;
    const int nt = K / BK;
    int Rr[2], Cc[2]; unsigned voffB[2];
#pragma unroll
    for (int i = 0; i < 2; ++i) { int R, C; stage_rc(tid * 16 + i * 8192, R, C); const int Rb = Epi::PERM ? ((R & ~31) + perm32(R & 31)) : R;
        Rr[i] = R; Cc[i] = C; voffB[i] = (unsigned)(Rb * K + C) * 2u; }
    const size_t kstep = (size_t)(BK * 2);
    const size_t hstepB = (size_t)HALF * K * 2;
    const unsigned ldsw = (unsigned)wid * 1024u;
    const int aoff = lds_byte(wr * 64 + fr, fq * 8), boff = lds_byte(wc * 32 + fr, fq * 8);
#define PG8_SA(b, h) (((b) * 2 + (h)) * HTB)
#define PG8_SB(b, h) ((4 + (b) * 2 + (h)) * HTB)
#define PG8_STAGE(bufoff, gbase, voff) do { _Pragma("unroll") for (int _i = 0; _i < 2; ++_i) \
        __builtin_amdgcn_global_load_lds((const unsigned*)((const char*)(gbase) + (voff)[_i]), (LAS unsigned*)(lds + (bufoff) + ldsw + _i * 8192), 16, 0, 0); } while (0)
#define PG8_LDA(dst, b, h) do { _Pragma("unroll") for (int m = 0; m < 4; ++m) _Pragma("unroll") for (int k = 0; k < 2; ++k) dst[m][k] = *(const LAS bf16x8*)(lds + PG8_SA(b, h) + aoff + m * 2048 + k * 1024); } while (0)
#define PG8_LDB(dst, b, h) do { _Pragma("unroll") for (int n = 0; n < 2; ++n) _Pragma("unroll") for (int k = 0; k < 2; ++k) dst[n][k] = *(const LAS bf16x8*)(lds + PG8_SB(b, h) + boff + n * 2048 + k * 1024); } while (0)
#define PG8_MMA(ai, bj, At, Bt) do { __builtin_amdgcn_s_setprio(1); _Pragma("unroll") for (int m = 0; m < 4; ++m) _Pragma("unroll") for (int n = 0; n < 2; ++n) _Pragma("unroll") for (int k = 0; k < 2; ++k) \
        acc[ai][bj][m][n] = __builtin_amdgcn_mfma_f32_16x16x32_bf16(Bt[n][k], At[m][k], acc[ai][bj][m][n], 0, 0, 0); __builtin_amdgcn_s_setprio(0); } while (0)
#define PG8_WAIT_V(n) asm volatile("s_waitcnt vmcnt(" #n ")" ::: "memory")
#define PG8_WAIT_L(n) asm volatile("s_waitcnt lgkmcnt(" #n ")" ::: "memory")
#define PG8_BAR __builtin_amdgcn_s_barrier()
#define PG8_SCHED __builtin_amdgcn_sched_barrier(0)
    Unit cur, nxt; int ui = 0;
    if (!S.next(0, cur)) return;
    f32x4 acc[2][2][4][2];
#pragma unroll
    for (int a = 0; a < 2; ++a)
#pragma unroll
        for (int b = 0; b < 2; ++b)
#pragma unroll
            for (int m = 0; m < 4; ++m)
#pragma unroll
                for (int n = 0; n < 2; ++n) acc[a][b][m][n] = (f32x4){0.f, 0.f, 0.f, 0.f};
    bf16x8 At[4][2], B0[2][2], B1[2][2];
    unsigned vo[2][2];
    S.aoff(cur, Rr, Cc, vo);
    {
        const char* cA = cur.A; const char* cB = cur.B;
        PG8_STAGE(PG8_SB(0, 0), cB, voffB); PG8_STAGE(PG8_SB(0, 1), cB + hstepB, voffB); PG8_STAGE(PG8_SA(0, 0), cA, vo[0]); PG8_STAGE(PG8_SA(0, 1), cA, vo[1]);
        if (wr == 1) PG8_BAR;
        PG8_WAIT_V(2); PG8_BAR;
        PG8_STAGE(PG8_SB(1, 0), cB + kstep, voffB); PG8_STAGE(PG8_SA(1, 0), cA + kstep, vo[0]); PG8_STAGE(PG8_SB(1, 1), cB + hstepB + kstep, voffB);
        PG8_WAIT_V(6); PG8_BAR;
    }
    for (;;) {
        const bool has_next = S.next(ui + 1, nxt);
        const char* cA = cur.A; const char* cB = cur.B;
        const char* nA = has_next ? nxt.A : cA; const char* nB = has_next ? nxt.B : cB;
        const bool full = Sched::ALWAYS_FULL ? true : (cur.nvalid > 128);
        for (int t = 0; t < nt; t += 2) {
            const bool last = (t == nt - 2);
            const char* a1 = cA + (size_t)(t + 1) * kstep;
            const char* a2 = last ? nA : cA + (size_t)(t + 2) * kstep; const char* b2 = last ? nB : cB + (size_t)(t + 2) * kstep;
            const char* a3 = a2 + kstep; const char* b3 = b2 + kstep;
            PG8_LDB(B0, 0, 0); PG8_LDB(B1, 0, 1); PG8_SCHED; PG8_LDA(At, 0, 0); PG8_STAGE(PG8_SA(1, 1), a1, vo[1]);
            if (last && has_next) S.aoff(nxt, Rr, Cc, vo);
            PG8_WAIT_V(8); PG8_WAIT_L(0); PG8_BAR; PG8_MMA(0, 0, At, B0); PG8_MMA(0, 1, At, B1); PG8_BAR; PG8_SCHED;
            PG8_LDA(At, 0, 1); PG8_STAGE(PG8_SB(0, 0), b2, voffB); PG8_STAGE(PG8_SB(0, 1), b2 + hstepB, voffB); PG8_STAGE(PG8_SA(0, 0), a2, vo[0]);
            PG8_WAIT_V(8); PG8_WAIT_L(0); PG8_BAR; if (full) { PG8_MMA(1, 0, At, B0); PG8_MMA(1, 1, At, B1); } PG8_BAR; PG8_SCHED;
            PG8_LDB(B0, 1, 0); PG8_LDB(B1, 1, 1); PG8_SCHED; PG8_LDA(At, 1, 0); PG8_STAGE(PG8_SA(0, 1), a2, vo[1]);
            PG8_WAIT_V(8); PG8_WAIT_L(0); PG8_BAR; PG8_MMA(0, 0, At, B0); PG8_MMA(0, 1, At, B1); PG8_BAR; PG8_SCHED;
            PG8_LDA(At, 1, 1); PG8_STAGE(PG8_SB(1, 0), b3, voffB); PG8_STAGE(PG8_SB(1, 1), b3 + hstepB, voffB); PG8_STAGE(PG8_SA(1, 0), a3, vo[0]);
            PG8_WAIT_V(8); PG8_WAIT_L(0); PG8_BAR; if (full) { PG8_MMA(1, 0, At, B0); PG8_MMA(1, 1, At, B1); } PG8_BAR; PG8_SCHED;
        }
        if constexpr (ALIGN_EPI) { if (wr == 0) PG8_BAR; }
        E(acc, cur, wr, wc, fr, fq);
        if (!has_next) break;
#pragma unroll
        for (int a = 0; a < 2; ++a)
#pragma unroll
            for (int b = 0; b < 2; ++b)
#pragma unroll
                for (int m = 0; m < 4; ++m)
#pragma unroll
                    for (int n = 0; n < 2; ++n) acc[a][b][m][n] = (f32x4){0.f, 0.f, 0.f, 0.f};
        cur = nxt; ++ui;
        if constexpr (ALIGN_EPI) { if (wr == 1) PG8_BAR; }
    }
    PG8_WAIT_V(0);
    if constexpr (!ALIGN_EPI) { if (wr == 0) PG8_BAR; }
    PG8_BAR;
#undef PG8_SA
#undef PG8_SB
#undef PG8_STAGE
#undef PG8_LDA
#undef PG8_LDB
#undef PG8_MMA
#undef PG8_WAIT_V
#undef PG8_WAIT_L
#undef PG8_BAR
#undef PG8_SCHED
}

template <bool ODD> struct EpiZ {
    static constexpr bool PERM = true;
    bf16_t* Z; float* vstat; const float* rstd;
    __device__ __forceinline__ void operator()(const f32x4 (&acc)[2][2][4][2], const Unit& u, int wr, int wc, int fr, int fq) const {
        const int row0 = u.rowbase + wr * 64 + fr; const int col0 = u.pn * BM + wc * 32 + 8 * fq;
        float rsv[2][4];
#pragma unroll
        for (int ai = 0; ai < 2; ++ai)
#pragma unroll
            for (int m = 0; m < 4; ++m) rsv[ai][m] = rstd[row0 + ai * HALF + m * 16];
#pragma unroll
        for (int ai = 0; ai < 2; ++ai)
#pragma unroll
            for (int m = 0; m < 4; ++m) {
                const int row = row0 + ai * HALF + m * 16;
                bf16_t* rowp = Z + (size_t)row * ZP + col0;
                float s = 0.f, q = 0.f;
#pragma unroll
                for (int bj = 0; bj < 2; ++bj) {
                    f32x4 v0 = acc[ai][bj][m][0] * rsv[ai][m], v1 = acc[ai][bj][m][1] * rsv[ai][m];
                    if (ODD) {
#pragma unroll
                        for (int j = 0; j < 4; ++j) { v0[j] = gelu_tanh(v0[j]); v1[j] = gelu_tanh(v1[j]); s += v0[j] + v1[j]; q += v0[j] * v0[j] + v1[j] * v1[j]; }
                    }
                    u32x4 w; w.x = cvt_pk_bf16(v0[0], v0[1]); w.y = cvt_pk_bf16(v0[2], v0[3]); w.z = cvt_pk_bf16(v1[0], v1[1]); w.w = cvt_pk_bf16(v1[2], v1[3]);
                    *(u32x4*)(rowp + bj * HALF) = w;
                }
                if (ODD) {
                    s += __shfl_xor(s, 16); s += __shfl_xor(s, 32); q += __shfl_xor(q, 16); q += __shfl_xor(q, 32);
                    if (u.pn >= 4 && fq == 0) *(f32x2*)(vstat + ((size_t)row * 16 + (u.pn - 4) * 4 + wc) * 2) = (f32x2){s, q};
                }
            }
    }
};
struct EpiResid {
    static constexpr bool PERM = true;
    const bf16_t* __restrict__ Xin; bf16_t* __restrict__ Xout;
    __device__ __forceinline__ void operator()(const f32x4 (&acc)[2][2][4][2], const Unit& u, int wr, int wc, int fr, int fq) const {
        const int row0 = u.rowbase + wr * 64 + fr, col0 = u.pn * BM + wc * 32 + 8 * fq;
#pragma unroll
        for (int ai = 0; ai < 2; ++ai) {
            u32x4 t[4][2];
#pragma unroll
            for (int m = 0; m < 4; ++m) { const bf16_t* rowp = Xin + (size_t)(row0 + ai * HALF + m * 16) * DM + col0;
#pragma unroll
                for (int bj = 0; bj < 2; ++bj) t[m][bj] = *(const u32x4*)(rowp + bj * HALF); }
#pragma unroll
            for (int m = 0; m < 4; ++m) { bf16_t* rowp = Xout + (size_t)(row0 + ai * HALF + m * 16) * DM + col0;
#pragma unroll
                for (int bj = 0; bj < 2; ++bj) { const f32x4 v0 = acc[ai][bj][m][0], v1 = acc[ai][bj][m][1]; const u32x4 x = t[m][bj]; u32x4 w;
                    w.x = cvt_pk_bf16(bf_lo(x.x) + v0[0], bf_hi(x.x) + v0[1]); w.y = cvt_pk_bf16(bf_lo(x.y) + v0[2], bf_hi(x.y) + v0[3]);
                    w.z = cvt_pk_bf16(bf_lo(x.z) + v1[0], bf_hi(x.z) + v1[1]); w.w = cvt_pk_bf16(bf_lo(x.w) + v1[2], bf_hi(x.w) + v1[3]);
                    *(u32x4*)(rowp + bj * HALF) = w; } }
        }
    }
};
}

struct Args { const float* in[20]; float* out; unsigned char* ws; int ph_lo, ph_hi; };
static_assert(sizeof(Args) == 184, "Args layout");
struct Frame {
    LAS unsigned char* lds;
};
#define F_TID (opaque_tid())
#define F_LANE (opaque_tid() & 63)
#define F_WAVE (__builtin_amdgcn_readfirstlane(opaque_tid() >> 6))
#define F_G ((int)gridDim.x)
#define F_BID ((int)blockIdx.x)
#define CAS __attribute__((address_space(4)))
__device__ __forceinline__ const CAS char* karg_base() { const CAS char* p = (const CAS char*)__builtin_amdgcn_kernarg_segment_ptr(); asm volatile("" : "+s"(p)); return p; }
#define KIN(k) ((const float*)(*(const GAS float* const CAS*)(karg_base() + 8 * (k))))
#define F_WS ((unsigned char*)(*(GAS unsigned char* const CAS*)(karg_base() + 168)))
#define F_X ((float*)(*(GAS float* const CAS*)(karg_base() + 160)))
#define F_CTL ((unsigned*)(F_WS + WS_CTL))

namespace pg4 {
constexpr int BPL = 4352;
struct Unit4 { int rowbase; int pn; int nvalid; int slot; };
__device__ __forceinline__ int off32(int r, int c) { const int ob = (r & 15) * 64 + c * 2; return (r >> 4) * 1024 + (ob ^ (((ob >> 9) & 1) << 5)); }
__device__ __forceinline__ void stage_rc32(int b, int& R, int& C) { const int st = b >> 10, sb = b & 1023, swz = sb ^ (((sb >> 9) & 1) << 5); R = st * 16 + (swz >> 6); C = (swz & 63) >> 1; }

__device__ __forceinline__ void epi_gu4(bf16_t* H, const LAS float* rstd, const f32x4 (&acc)[8][4], const Unit4& u, int wr, int wc, int fr, int fq) {
    asm volatile("" : "+v"(fr), "+v"(fq));
    const int col0 = u.pn * 128 + wc * 32 + 8 * fq;
    const __amdgpu_buffer_rsrc_t hrs = __builtin_amdgcn_make_buffer_rsrc(H, 0, NR_ALLOC * DE * 2, 0x00020000);
#pragma unroll
    for (int m = 0; m < 8; ++m) {
        const int lr = wr * 128 + m * 16 + fr;
        if (lr < u.nvalid) {
            const float rr = rstd[u.slot * 256 + lr];
            const f32x4 g0 = acc[m][0] * rr, g1 = acc[m][1] * rr, u0 = acc[m][2] * rr, u1 = acc[m][3] * rr; u32x4 w;
            w.x = cvt_pk_bf16(silu_f(g0[0]) * u0[0], silu_f(g0[1]) * u0[1]); w.y = cvt_pk_bf16(silu_f(g0[2]) * u0[2], silu_f(g0[3]) * u0[3]);
            w.z = cvt_pk_bf16(silu_f(g1[0]) * u1[0], silu_f(g1[1]) * u1[1]); w.w = cvt_pk_bf16(silu_f(g1[2]) * u1[2], silu_f(g1[3]) * u1[3]);
            __builtin_amdgcn_raw_buffer_store_b128(w, hrs, (unsigned)(((u.rowbase + lr) * DE + col0) * 2), 0,   16);
        }
    }
}
__device__ __forceinline__ void epi_down4(bf16_t* Y, const LAS float* gates, const f32x4 (&acc)[8][4], const Unit4& u, int wr, int wc, int fr, int fq) {
    asm volatile("" : "+v"(fr), "+v"(fq));
    const int col0 = u.pn * 256 + wc * 64 + 16 * fq;
#pragma unroll
    for (int m = 0; m < 8; ++m) {
        const int lr = wr * 128 + m * 16 + fr;
        if (lr < u.nvalid) {
            const float g = gates[u.slot * 256 + lr];
#pragma unroll
            for (int n2 = 0; n2 < 2; ++n2) { const f32x4 v0 = acc[m][2 * n2] * g, v1 = acc[m][2 * n2 + 1] * g; u32x4 w;
                w.x = cvt_pk_bf16(v0[0], v0[1]); w.y = cvt_pk_bf16(v0[2], v0[3]); w.z = cvt_pk_bf16(v1[0], v1[1]); w.w = cvt_pk_bf16(v1[2], v1[3]);
                *(u32x4*)(Y + (size_t)(u.rowbase + lr) * DM + col0 + 8 * n2) = w; }
        }
    }
}
template <int MODE  , int NT  , int LDB>
__device__ __forceinline__ void gemm4_phase(LAS unsigned char* lds, const LAS int* tab, const LAS unsigned short* toks, const LAS float* gates  , const char* Abase, const float* W0, const float* W1, const float* Gk, bf16_t* Out, const int layer, const int nunits) {
    const int tid = opaque_tid(), wid = __builtin_amdgcn_readfirstlane(tid >> 6), lane = tid & 63, wr = wid >> 2, wc = wid & 3, fr = lane & 15, fq = lane >> 4;
    if (nunits <= 0) return;
    constexpr int ABLK = 32768, BOFF = 3 * ABLK, BSTG = 4 * BPL;
    const unsigned ldsw = (unsigned)wid * 1024u;
    const int aoff = wr * 16384 + pg8::lds_byte(fr, fq * 8);
    const int boff = BOFF + fq * BPL + ((fr & 3) * 68 + ((wc * 64 + fr) >> 2)) * 16;
    const int kg = wid, ng = lane;
    const unsigned bw0 = (unsigned)(BOFF + (kg >> 1) * BPL + ng * 16 + 8 * (kg & 1));
    const int bsel = MODE == 0 ? ((ng >> 3) & 1) : 0;
    const int bcolv = MODE == 0 ? (32 * (ng >> 4) + 8 * (ng & 3) + 4 * ((ng >> 2) & 1)) : (64 * (ng >> 4) + 16 * (ng & 3) + 4 * ((ng >> 2) & 3));
    const unsigned bthr = (unsigned)((4 * kg * LDB + bcolv) * 4);
    const int TT = nunits * NT;
    Unit4 uc; int sa = 0, sb = 0, sc2 = 0, ka = 0, kb = 0, kc = 0;
#define G4_NEXTC(i) do { uc.rowbase = __builtin_amdgcn_readfirstlane(tab[(i) * 8 + 3]); uc.nvalid = __builtin_amdgcn_readfirstlane(tab[(i) * 8 + 4]); uc.pn = __builtin_amdgcn_readfirstlane(tab[(i) * 8 + 2]); uc.slot = (i); } while (0)
#define G4_NEXTA(i) do { if (MODE == 0) curA = Abase; else curA = Abase + (size_t)__builtin_amdgcn_readfirstlane(tab[(i) * 8 + 3]) * DE * 2; \
        _Pragma("unroll") for (int _h = 0; _h < 2; ++_h) _Pragma("unroll") for (int _i = 0; _i < 2; ++_i) { int _R, _C; pg8::stage_rc(tid * 16 + _i * 8192, _R, _C); \
            vo[_h][_i] = MODE == 0 ? (unsigned)(((int)toks[(i) * 256 + _h * 128 + _R] * DM + _C) * 2) : (unsigned)(((_h * 128 + _R) * DE + _C) * 2); } } while (0)
#define G4_NEXTB(i) do { const int _e = __builtin_amdgcn_readfirstlane(tab[(i) * 8 + 0]), _ct = __builtin_amdgcn_readfirstlane(tab[(i) * 8 + 2]); \
        if (MODE == 0) { const size_t _wo = (size_t)(layer * NE + _e) * DM * DE + (size_t)_ct * 128; curB0 = W0 + _wo; curB1 = W1 + _wo; } \
        else { curB0 = W0 + (size_t)(layer * NE + _e) * DE * DM + (size_t)_ct * 256; curB1 = curB0; } } while (0)
    const char* curA; const float* curB0; const float* curB1; unsigned vo[2][2];
    G4_NEXTC(0); G4_NEXTA(0); G4_NEXTB(0);
    f32x4 acc[8][4];
#pragma unroll
    for (int m = 0; m < 8; ++m)
#pragma unroll
        for (int n = 0; n < 4; ++n) acc[m][n] = (f32x4){0.f, 0.f, 0.f, 0.f};
    f32x4 Br[3][4];
#define G4_ISSUE_A(blk) do { const char* _ap = curA + (size_t)ka * 128; \
        _Pragma("unroll") for (int _h = 0; _h < 2; ++_h) _Pragma("unroll") for (int _i = 0; _i < 2; ++_i) \
            __builtin_amdgcn_global_load_lds((const unsigned*)(_ap + vo[_h][_i]), (LAS unsigned*)(lds + (blk) * ABLK + _h * 16384 + ldsw + _i * 8192), 16, 0, 0); \
        if (++ka == NT / 2) { ka = 0; if (sa + 1 < nunits) { ++sa; G4_NEXTA(sa); } } } while (0)
#define G4_ISSUE_B(rs) do { const char* _bp = (const char*)(bsel ? curB1 : curB0) + (size_t)kb * (32 * LDB * 4) + bthr; \
        _Pragma("unroll") for (int _j = 0; _j < 4; ++_j) { const char* _p = _bp + (size_t)_j * (LDB * 4); \
            asm volatile("global_load_dwordx4 %0, %1, off ; G4_BLOAD" : "=&v"(Br[rs][_j]) : "v"(_p) : "memory"); } \
        if (++kb == NT) { kb = 0; if (sb + 1 < nunits) { ++sb; G4_NEXTB(sb); } } } while (0)
    f32x4 gq[2] = {(f32x4){1.f, 1.f, 1.f, 1.f}, (f32x4){1.f, 1.f, 1.f, 1.f}};
#define G4_LOAD_G(q, kstep) do { if (MODE == 0) { const float* _gp = Gk + (((kstep) & (NT - 1)) * 32 + 4 * kg); asm volatile("s_load_dwordx4 %0, %1, 0x0" : "=s"(gq[q]) : "s"(_gp) : "memory"); } } while (0)
#define G4_FENCE_G() do { if (MODE == 0) asm volatile("" : "+s"(gq[0]), "+s"(gq[1])); } while (0)
#define G4_WRITE_B(rs, bst, q) do { _Pragma("unroll") for (int _i = 0; _i < 4; ++_i) { u32x2 _w; \
        if (MODE == 0) { _w.x = cvt_pk_bf16(Br[rs][0][_i] * gq[q][0], Br[rs][1][_i] * gq[q][1]); _w.y = cvt_pk_bf16(Br[rs][2][_i] * gq[q][2], Br[rs][3][_i] * gq[q][3]); } \
        else { _w.x = cvt_pk_bf16(Br[rs][0][_i], Br[rs][1][_i]); _w.y = cvt_pk_bf16(Br[rs][2][_i], Br[rs][3][_i]); } \
        *(LAS u32x2*)(lds + (bst) * BSTG + bw0 + 1088 * _i) = _w; } } while (0)
#define G4_WAIT_V(n) asm volatile("s_waitcnt vmcnt(" #n ")" ::: "memory")
#define G4_WAIT_L(n) asm volatile("s_waitcnt lgkmcnt(" #n ")" ::: "memory")
    G4_LOAD_G(0, 0); G4_LOAD_G(1, 1);
    G4_ISSUE_B(0); G4_WAIT_V(0); G4_WAIT_L(0); G4_FENCE_G(); G4_WRITE_B(0, 0, 0); G4_ISSUE_A(0); G4_ISSUE_A(1); G4_ISSUE_B(1); G4_ISSUE_B(2);
    G4_WAIT_V(12);
    int pendT = 0, pendB = 0; bool act0 = (wr < 1) || uc.nvalid > 128;
    int T = 0;
    bf16x8 Bf[4], Af[4];
#pragma unroll
    for (int i = 0; i < 4; ++i) { Bf[i] = (bf16x8){0, 0, 0, 0, 0, 0, 0, 0}; Af[i] = (bf16x8){0, 0, 0, 0, 0, 0, 0, 0}; }
#define G4_WAIT_TOP() do { if (pendT) { if (MODE == 0) G4_WAIT_V(28); else G4_WAIT_V(36); --pendT; } else G4_WAIT_V(20); } while (0)
#define G4_WAIT_B() do { if (pendB) { if (MODE == 0) G4_WAIT_V(16); else G4_WAIT_V(24); --pendB; } else G4_WAIT_V(8); } while (0)
#define G4_STEP(ab, p, rs) do { \
        if ((p) == 0) { G4_WAIT_TOP(); } \
        G4_WAIT_L(0); G4_FENCE_G(); __builtin_amdgcn_s_barrier(); \
        if ((p) == 0) { G4_ISSUE_A(((ab) + 2) % 3); } \
        if (act0) { \
            _Pragma("unroll") for (int n = 0; n < 4; ++n) Bf[n] = *(const LAS bf16x8*)(lds + (p) * BSTG + boff + n * 64); \
            _Pragma("unroll") for (int m = 0; m < 4; ++m) Af[m] = *(const LAS bf16x8*)(lds + (ab) * ABLK + aoff + m * 2048 + (p) * 1024); } \
        G4_WAIT_B(); asm volatile("; G4_BWAIT" ::: "memory"); \
        G4_WRITE_B(((rs) + 1) % 3, 1 - (p), 1 - (p)); G4_LOAD_G(p, T + 2); \
        G4_ISSUE_B(rs); \
        if (act0) { __builtin_amdgcn_s_setprio(1); \
            _Pragma("unroll") for (int m = 0; m < 4; ++m) _Pragma("unroll") for (int n = 0; n < 4; ++n) acc[m][n] = __builtin_amdgcn_mfma_f32_16x16x32_bf16(Bf[n], Af[m], acc[m][n], 0, 0, 0); \
            __builtin_amdgcn_s_setprio(0); \
            _Pragma("unroll") for (int m = 0; m < 4; ++m) Af[m] = *(const LAS bf16x8*)(lds + (ab) * ABLK + aoff + (m + 4) * 2048 + (p) * 1024); \
            __builtin_amdgcn_s_setprio(1); \
            _Pragma("unroll") for (int m = 0; m < 4; ++m) _Pragma("unroll") for (int n = 0; n < 4; ++n) acc[m + 4][n] = __builtin_amdgcn_mfma_f32_16x16x32_bf16(Bf[n], Af[m], acc[m + 4][n], 0, 0, 0); \
            __builtin_amdgcn_s_setprio(0); } \
        if (++kc == NT) { kc = 0; \
            if (MODE == 0) epi_gu4(Out, gates, acc, uc, wr, wc, fr, fq); else epi_down4(Out, gates, acc, uc, wr, wc, fr, fq); \
            if (wr < 1 || uc.nvalid > 128) { pendT = 2; pendB = 2; } else { pendT = 0; pendB = 0; } \
            _Pragma("unroll") for (int m = 0; m < 8; ++m) _Pragma("unroll") for (int n = 0; n < 4; ++n) acc[m][n] = (f32x4){0.f, 0.f, 0.f, 0.f}; \
            if (sc2 + 1 < nunits) { ++sc2; G4_NEXTC(sc2); act0 = (wr < 1) || uc.nvalid > 128; } } \
        ++T; } while (0)
    while (T + 6 <= TT) { G4_STEP(0, 0, 0); G4_STEP(0, 1, 1); G4_STEP(1, 0, 2); G4_STEP(1, 1, 0); G4_STEP(2, 0, 1); G4_STEP(2, 1, 2); }
    if (T + 2 <= TT) { G4_STEP(0, 0, 0); G4_STEP(0, 1, 1);
        if (T + 2 <= TT) { G4_STEP(1, 0, 2); G4_STEP(1, 1, 0); } }
    G4_WAIT_V(0); G4_WAIT_L(0); __builtin_amdgcn_s_barrier();
#pragma unroll
    for (int rs = 0; rs < 3; ++rs)
#pragma unroll
        for (int j = 0; j < 4; ++j) asm volatile("" :: "v"(Br[rs][j]));
#undef G4_NEXTA
#undef G4_NEXTB
#undef G4_NEXTC
#undef G4_ISSUE_A
#undef G4_ISSUE_B
#undef G4_WRITE_B
#undef G4_LOAD_G
#undef G4_FENCE_G
#undef G4_WAIT_V
#undef G4_WAIT_L
#undef G4_WAIT_TOP
#undef G4_WAIT_B
#undef G4_STEP
}
}

struct MoeTabs { LAS int* cnt; LAS int* seg; LAS int* fst; LAS int* hst; LAS int* tab; LAS int* nmy; LAS unsigned short* toks; LAS float* gates; LAS float* rstd; };
__device__ __forceinline__ MoeTabs moe_tabs(Frame& F) {
    MoeTabs T; LAS unsigned char* m = F.lds + MISC_OFF;
    T.cnt = (LAS int*)(m + MO_CNT); T.seg = (LAS int*)(m + MO_SEG); T.fst = (LAS int*)(m + MO_FST); T.hst = (LAS int*)(m + MO_HST); T.tab = (LAS int*)(m + MO_TAB); T.nmy = (LAS int*)(m + MO_NMY);
    T.toks = (LAS unsigned short*)(m + MO_TOKS); T.gates = (LAS float*)(m + MO_GATES); T.rstd = (LAS float*)(m + MO_RSTD); return T;
}
__device__ __forceinline__ void moe_build_seg(Frame& F, const Args& AR, const MoeTabs& T, int layer) {
    __syncthreads();
    if (F_TID < NE) T.cnt[F_TID] = (int)__hip_atomic_load(F_CTL + CW_CNT + (layer * NE + F_TID) * 64, __ATOMIC_RELAXED, __HIP_MEMORY_SCOPE_AGENT);
    __syncthreads();
    if (F_TID < NE) {
        const int e = F_TID, c = T.cnt[e], nb = (c + 127) >> 7;
        int s = nb * 128, fs = (nb >> 1) * 4, hs = (nb & 1) * 4;
        const int s0 = s, f0 = fs, h0 = hs;
#pragma unroll
        for (int o = 1; o < 64; o <<= 1) { const int a = __shfl_up(s, o), b = __shfl_up(fs, o), d = __shfl_up(hs, o); if (e >= o) { s += a; fs += b; hs += d; } }
        T.seg[e] = s - s0; T.fst[e] = fs - f0; T.hst[e] = hs - h0;
        if (e == NE - 1) { T.seg[NE] = s; T.fst[NE] = fs; T.hst[NE] = hs; }
    }
    __syncthreads();
}
__device__ __forceinline__ int moe_build_units(Frame& F, const Args& AR, const MoeTabs& T, int layer, int base, bool build, const int nfull, const int total, const bool deal2, int& nfw, const int sl0 = 0  ) {
    const int vcu = (F_G % 8 == 0) ? (F_BID % 8) * (F_G / 8) + F_BID / 8 : F_BID;
    int n = (total - base - vcu + F_G - 1) / F_G; n = n < 0 ? 0 : (n > MAXU ? MAXU : n);
    const int rv = F_G - 1 - vcu;
    nfw = (nfull - vcu + F_G - 1) / F_G; nfw = nfw < 0 ? 0 : (nfw > MAXU ? MAXU : nfw);
    if (deal2) { int nhw = (total - nfull - rv + F_G - 1) / F_G; nhw = nhw < 0 ? 0 : nhw; n = nfw + nhw; n = n > MAXU ? MAXU : n; }
    if (!build) return n;
    if (F_TID < 64) {
        const int e = F_TID; const int fa = T.fst[e], fb = T.fst[e + 1], ha = T.hst[e], hb = T.hst[e + 1];
#pragma unroll
        for (int i = 0; i < MAXU; ++i) {
            if (i >= sl0 && i < n) {
                const int L = deal2 ? (i < nfw ? i * F_G + vcu : nfull + (i - nfw) * F_G + rv) : base + i * F_G + vcu;
                const bool isf = L < nfull; const int Lr = isf ? L : L - nfull;
                const bool mine = isf ? (fa <= Lr && Lr < fb) : (ha <= Lr && Lr < hb);
                const unsigned long long mk = __ballot(mine);
                const int ee = (int)__builtin_ctzll(mk);
                if (e == ee) { const int r = Lr - (isf ? fa : ha), c = T.cnt[e]; const int nb = (c + 127) >> 7;
                    const int rb = isf ? (r >> 2) : (nb >> 1), ct = r & 3;
                    LAS int* t = T.tab + i * 8; t[0] = e; t[1] = rb; t[2] = ct; t[3] = T.seg[e] + rb * 256; t[4] = isf ? 256 : 128; t[5] = c - rb * 256; }
            }
        }
    }
    __syncthreads();
    const i32x4* list = (const i32x4*)(F_WS + WS_LIST);
    {
        const int tid = F_TID, row = tid & 255, sh = tid >> 8;
        i32x4 v[MAXU / 2];
#pragma unroll
        for (int p = 0; p < MAXU / 2; ++p) { const int sl = 2 * p + sh; v[p] = (i32x4){ZERO_ROW, 0, 0, 0};
            if (sl >= sl0 && sl < n) { const int e = T.tab[sl * 8 + 0], rb = T.tab[sl * 8 + 1], cl = T.tab[sl * 8 + 5];
                if (row < cl) v[p] = list[(size_t)e * NT + rb * 256 + row]; } }
#pragma unroll
        for (int p = 0; p < MAXU / 2; ++p) { const int sl = 2 * p + sh;
            if (sl >= sl0 && sl < n) { const int vx = v[p].x, vy = v[p].y, vz = v[p].z; T.toks[sl * 256 + row] = (unsigned short)vx; T.gates[sl * 256 + row] = __int_as_float(vy); T.rstd[sl * 256 + row] = __int_as_float(vz); } }
    }
    __syncthreads();
    return n;
}
constexpr int BLK_CTRS = 384;
__device__ __forceinline__ bool moe_fusable(int nfull, int total, int G) { return total <= MAXU * G && ((nfull + G - 1) / G + (total - nfull + G - 1) / G) <= MAXU; }
__device__ __forceinline__ void moe_publish(Frame& F, const Args& AR, const MoeTabs& T, int layer, int n) {
    if (F_TID < 64) {
        if (F_TID < n) { unsigned* c = F_CTL + CW_BLK + ((size_t)layer * BLK_CTRS + (T.tab[F_TID * 8 + 3] >> 7)) * 16; (void)xb_add(c, 1u); }
    }
}
__device__ __forceinline__ void moe_wait(Frame& F, const Args& AR, const MoeTabs& T, int layer, int s0, int s1) {
    if (F_TID < 64) {
        const int i = s0 + F_TID;
        if (i < s1) { unsigned* c = F_CTL + CW_BLK + ((size_t)layer * BLK_CTRS + (T.tab[i * 8 + 3] >> 7)) * 16; unsigned* bar = F_CTL + CW_BAR;
            XB_SPIN(xb_ld(c) < 4u, bar); }
        if (F_TID == 0) __builtin_amdgcn_fence(__ATOMIC_ACQUIRE, "agent");
    }
    asm volatile("s_waitcnt vmcnt(0)" ::: "memory");
    __syncthreads();
}
__device__ __forceinline__ unsigned f2bf(float f) { unsigned u = __builtin_bit_cast(unsigned, f); return (u + 0x7fffu + ((u >> 16) & 1u)) >> 16; }
__device__ __forceinline__ unsigned pk2(float lo, float hi) { return f2bf(lo) | (f2bf(hi) << 16); }
__device__ __forceinline__ void p0_transpose_item(const float* W, int N, bf16_t* WT, int Kd, int k0, int n0, int drow0, LAS float* scr, int lane, const float* gk) {
#pragma unroll 8
    for (int i = 0; i < 32; ++i) { const int kk = 2 * i + (lane >> 5); scr[kk * 33 + (lane & 31)] = W[(size_t)(k0 + kk) * N + n0 + (lane & 31)]; }
    LDS_WAIT(); asm volatile("" ::: "memory");
    const int c = lane & 7;
    f32x4 g0 = (f32x4){1.f, 1.f, 1.f, 1.f}, g1 = g0;
    if (gk) { g0 = *(const f32x4*)(gk + k0 + 8 * c); g1 = *(const f32x4*)(gk + k0 + 8 * c + 4); }
#pragma unroll
    for (int j = 0; j < 4; ++j) { const int n = (lane >> 3) + 8 * j; const LAS float* s = scr + (8 * c) * 33 + n;
        u32x4 o; o.x = pk2(s[0 * 33] * g0.x, s[1 * 33] * g0.y); o.y = pk2(s[2 * 33] * g0.z, s[3 * 33] * g0.w); o.z = pk2(s[4 * 33] * g1.x, s[5 * 33] * g1.y); o.w = pk2(s[6 * 33] * g1.z, s[7 * 33] * g1.w);
        *(u32x4*)(WT + (size_t)(drow0 + n) * Kd + k0 + 8 * c) = o; }
    LDS_WAIT(); asm volatile("" ::: "memory");
}
__device__ __forceinline__ void row_rstd(const f32x4 (&v)[4], int lane, float* out) {
    float s = 0.f;
#pragma unroll
    for (int j = 0; j < 4; ++j) s += (v[j].x * v[j].x + v[j].y * v[j].y) + (v[j].z * v[j].z + v[j].w * v[j].w);
    const float rstd = 1.0f / sqrtf(wave_sum(s) * (1.f / DM) + EPS);
    if (lane == 0) *out = rstd;
}
__device__ __forceinline__ void norm_row(const f32x4 (&v)[4], const float* g, int lane, bf16_t* ob, float* of, float oscale = 1.0f) {
    float s = 0.f;
#pragma unroll
    for (int j = 0; j < 4; ++j) s += (v[j].x * v[j].x + v[j].y * v[j].y) + (v[j].z * v[j].z + v[j].w * v[j].w);
    const float rstd = oscale / sqrtf(wave_sum(s) * (1.f / DM) + EPS);
#pragma unroll
    for (int j = 0; j < 4; ++j) {
        const f32x4 gg = *((const f32x4*)g + lane + 64 * j);
        const f32x4 y = v[j] * rstd * gg;
        if (ob) { u32x2 w; w.x = cvt_pk_bf16(y.x, y.y); w.y = cvt_pk_bf16(y.z, y.w); *((u32x2*)ob + lane + 64 * j) = w; }
        if (of) *((f32x4*)of + lane + 64 * j) = y;
    }
}
__device__ __forceinline__ void p0_prologue(Frame& F, const Args& AR) {
    LAS float* scr = (LAS float*)(F.lds + F_WAVE * 16384);
    const int gw = F_BID * NWAVES + F_WAVE, NGW = F_G * NWAVES;
    bf16_t* WIN = (bf16_t*)(F_WS + WS_WIN); bf16_t* WOUT = (bf16_t*)(F_WS + WS_WOUT);
    constexpr int I_IN = 16 * 64, I_OUT = 16 * 32, I_MIX = NL * (I_IN + I_OUT);
    for (int it = gw; it < I_MIX; it += NGW) {
        if (it < NL * I_IN) { const int l = it / I_IN, r = it % I_IN, kb = r / 64, nb = r % 64;
            const float* W = ((l & 1) ? KIN(8) : KIN(4)) + (size_t)(l >> 1) * DM * 2048;
            p0_transpose_item(W, 2048, WIN + (size_t)l * 2048 * DM, DM, kb * 64, nb * 32, nb * 32, scr, F_LANE, KIN(1) + (size_t)l * DM); continue; }
        const int q = it - NL * I_IN, l = q / I_OUT, r = q % I_OUT, kb = r / 32, nb = r % 32;
        const float* W = ((l & 1) ? KIN(12) : KIN(5)) + (size_t)(l >> 1) * DM * DM;
        p0_transpose_item(W, DM, WOUT + (size_t)l * DM * DM, DM, kb * 64, nb * 32, nb * 32, scr, F_LANE, nullptr);
    }
    {
        bf16_t* WSB = (bf16_t*)(F_WS + WS_WSB); bf16_t* PWT = (bf16_t*)(F_WS + WS_PWT);
        const int gt = F_BID * NTHR + F_TID, NGT = F_G * NTHR;
        for (int i = gt; i < 2 * 8 * 128 * 128; i += NGT) { const int jj = i & 127, ii = (i >> 7) & 127; const float v = (jj <= ii) ? KIN(10)[i] : 0.f; WSB[i] = (bf16_t)f2bf(v); }
        bf16_t* WRH = (bf16_t*)(F_WS + WS_WRT); bf16_t* WRL = WRH + NL * 80 * 1024;
        for (int i = gt; i < NL * 80 * 1024; i += NGT) { const int k = i & 1023, n = (i >> 10) % 80, l = i / 81920;
            const float w = (n < 8 ? KIN(13)[((size_t)l * 1024 + k) * 8 + n] : (n < 72 ? KIN(15)[((size_t)l * 1024 + k) * 64 + n - 8] : 0.f)) * KIN(2)[l * 1024 + k];
            const unsigned hi = f2bf(w); const float rem = w - bf_lo(hi);
            WRH[i] = (bf16_t)hi; WRL[i] = (bf16_t)f2bf(rem); }
        for (int i = gt; i < 2 * 4 * 128 * 128; i += NGT) { const int c = i & 127, d = (i >> 7) & 127, lg2 = i >> 14; PWT[i] = (bf16_t)f2bf(KIN(6)[(size_t)lg2 * 16384 + c * 128 + d]); }
    }
    bf16_t* XBz = (bf16_t*)(F_WS + WS_XB);
    for (int m = gw; m < NT; m += NGW) {
        const f32x4* xr = (const f32x4*)(KIN(0) + (size_t)m * DM) + F_LANE; f32x4 v[4];
#pragma unroll
        for (int j = 0; j < 4; ++j) { v[j] = xr[64 * j]; u32x2 w; w.x = cvt_pk_bf16(v[j].x, v[j].y); w.y = cvt_pk_bf16(v[j].z, v[j].w); *((u32x2*)((bf16_t*)(F_WS + WS_X16) + (size_t)m * DM) + F_LANE + 64 * j) = w; }
        row_rstd(v, F_LANE, (float*)(F_WS + WS_RSTD) + m);
    }
    if (gw == 0) { for (int j = 0; j < 4; ++j) *((u32x2*)(XBz + (size_t)ZERO_ROW * DM) + F_LANE + 64 * j) = (u32x2){0u, 0u}; }
}

typedef float f32x16 __attribute__((ext_vector_type(16)));
typedef short s16x4 __attribute__((ext_vector_type(4)));
constexpr int ATT_RS = 144;
constexpr int ATT_VBUF = 32 * ATT_RS;
__device__ __forceinline__ void attn_mfma(Frame& F, const Args& AR) {
    const bf16_t* Z = (const bf16_t*)(F_WS + WS_Z); bf16_t* YM = (bf16_t*)(F_WS + WS_YM);
    const int lane = F_LANE, l31 = lane & 31, hh = lane >> 5;
    LAS unsigned char* vbuf = F.lds + F_WAVE * (2 * ATT_VBUF);
    const int gi = (lane >> 4) & 1, q4 = (lane & 15) >> 2, p4 = lane & 3;
    const unsigned troff = (unsigned)((4 * hh + q4) * ATT_RS + (16 * gi + 4 * p4) * 2);
    const int vr8 = lane >> 3, vcol = lane & 7;
    const float SC = 0.125f * 1.4426950408889634f;
    const int NJOB = 2048, W0 = F_BID * NWAVES + F_WAVE, NW = F_G * NWAVES;
    for (int job = W0; job < NJOB; job += NW) {
        const int bh = job >> 5, b = bh >> 3, head = bh & 7, gp = (job >> 2) & 7, r = job & 3;
        for (int half = 0; half < 2; ++half) {
            const int g = half ? 15 - gp : gp;
            const int tq = b * SEQ + 128 * g + 4 * l31 + r;
            bf16x8 Qf[4];
#pragma unroll
            for (int s2 = 0; s2 < 4; ++s2) Qf[s2] = *(const bf16x8*)(Z + (size_t)tq * ZP + 512 + head * 64 + 16 * s2 + 8 * hh);
            f32x16 O0, O1;
#pragma unroll
            for (int i = 0; i < 16; ++i) { O0[i] = 0.f; O1[i] = 0.f; }
            float m = -INFINITY, l = 0.f;
            const int nA0 = (g == 0) ? 4 : 0, nA = 8 - nA0, nblk = nA + g + 1;
            bf16x8 Kn[4]; u32x4 Vn[4];
            { const int kstart = 128 * g - 128 + 32 * nA0;
              const bf16_t* kp = Z + (size_t)(b * SEQ + kstart + l31) * ZP + 1024 + head * 64 + 8 * hh;
#pragma unroll
              for (int s2 = 0; s2 < 4; ++s2) Kn[s2] = *(const bf16x8*)(kp + 16 * s2);
              const bf16_t* vp = Z + (size_t)(b * SEQ + kstart + vr8) * ZP + 1536 + head * 64 + 8 * vcol;
#pragma unroll
              for (int c4 = 0; c4 < 4; ++c4) Vn[c4] = *(const u32x4*)(vp + (size_t)c4 * 8 * ZP); }
            for (int n = 0; n < nblk; ++n) {
                const bool passA = n < nA;
                const int kstart = passA ? (128 * g - 128 + 32 * (nA0 + n)) : 32 * (n - nA);
                bf16x8 Kc[4];
#pragma unroll
                for (int s2 = 0; s2 < 4; ++s2) Kc[s2] = Kn[s2];
                LAS unsigned char* vb = vbuf + (n & 1) * ATT_VBUF;
#pragma unroll
                for (int c4 = 0; c4 < 4; ++c4) *(LAS u32x4*)(vb + (8 * c4 + vr8) * ATT_RS + vcol * 16) = Vn[c4];
                if (n + 1 < nblk) {
                    const int n1 = n + 1; const bool pA = n1 < nA;
                    const int ks1 = pA ? (128 * g - 128 + 32 * (nA0 + n1)) : 32 * (n1 - nA);
                    const int tk = pA ? (b * SEQ + ks1 + l31) : (b * SEQ + 4 * (ks1 + l31) + r);
                    const int tv = pA ? (b * SEQ + ks1 + vr8) : (b * SEQ + 4 * (ks1 + vr8) + r);
                    const bf16_t* kp = Z + (size_t)tk * ZP + 1024 + head * 64 + 8 * hh;
#pragma unroll
                    for (int s2 = 0; s2 < 4; ++s2) Kn[s2] = *(const bf16x8*)(kp + 16 * s2);
                    const bf16_t* vp = Z + (size_t)tv * ZP + 1536 + head * 64 + 8 * vcol; const size_t vstep = (size_t)(pA ? 8 : 32) * ZP;
#pragma unroll
                    for (int c4 = 0; c4 < 4; ++c4) Vn[c4] = *(const u32x4*)(vp + c4 * vstep);
                }
                f32x16 S;
#pragma unroll
                for (int i = 0; i < 16; ++i) S[i] = 0.f;
#pragma unroll
                for (int s2 = 0; s2 < 4; ++s2) S = __builtin_amdgcn_mfma_f32_32x32x16_bf16(Kc[s2], Qf[s2], S, 0, 0, 0);
                const int qpos = passA ? (128 * g + 4 * l31 + r) : (32 * g + l31);
                const int dbase = qpos - kstart - 4 * hh;
                float bm = -INFINITY; float P[16];
                if (passA) {
#pragma unroll
                    for (int i = 0; i < 16; ++i) { const int d = dbase - ((i & 3) + 8 * (i >> 2));
                        const float sv = ((unsigned)d <= 128u) ? S[i] * SC : -INFINITY; S[i] = sv; bm = fmaxf(bm, sv); }
                } else {
#pragma unroll
                    for (int i = 0; i < 16; ++i) { const int d = dbase - ((i & 3) + 8 * (i >> 2));
                        const bool v1 = (unsigned)d <= 128u, v2 = d >= 0 && (d & 3) == 0;
                        const float sv = (v1 || v2) ? S[i] * SC + ((v1 && v2) ? 1.0f : 0.0f) : -INFINITY; S[i] = sv; bm = fmaxf(bm, sv); }
                }
                bm = fmaxf(bm, __shfl_xor(bm, 32));
                if (__builtin_amdgcn_ballot_w64(bm > m) != 0ull) {
                    const float mnew = fmaxf(m, bm);
                    const float msafe0 = (mnew == -INFINITY) ? 0.f : mnew;
                    const float alpha = __builtin_amdgcn_exp2f(m - msafe0);
                    m = mnew; l *= alpha;
#pragma unroll
                    for (int i = 0; i < 16; ++i) { O0[i] *= alpha; O1[i] *= alpha; }
                }
                const float msafe = (m == -INFINITY) ? 0.f : m;
                float ps = 0.f;
#pragma unroll
                for (int i = 0; i < 16; ++i) { const float p = __builtin_amdgcn_exp2f(S[i] - msafe); P[i] = p; ps += p; }
                l += ps;
                bf16x8 Pf[2];
#pragma unroll
                for (int s2 = 0; s2 < 2; ++s2) {
                    u32x4 pk; pk.x = cvt_pk_bf16(P[8 * s2 + 0], P[8 * s2 + 1]); pk.y = cvt_pk_bf16(P[8 * s2 + 2], P[8 * s2 + 3]);
                    pk.z = cvt_pk_bf16(P[8 * s2 + 4], P[8 * s2 + 5]); pk.w = cvt_pk_bf16(P[8 * s2 + 6], P[8 * s2 + 7]);
                    Pf[s2] = __builtin_bit_cast(bf16x8, pk);
                }
                const unsigned va = (unsigned)(size_t)vb + troff;
                s16x4 v000, v001, v010, v011, v100, v101, v110, v111;
                asm volatile("s_waitcnt lgkmcnt(0)\n\t"
                             "ds_read_b64_tr_b16 %0, %8\n\t"
                             "ds_read_b64_tr_b16 %1, %8 offset:%9\n\t"
                             "ds_read_b64_tr_b16 %2, %8 offset:%10\n\t"
                             "ds_read_b64_tr_b16 %3, %8 offset:%11\n\t"
                             "ds_read_b64_tr_b16 %4, %8 offset:64\n\t"
                             "ds_read_b64_tr_b16 %5, %8 offset:%12\n\t"
                             "ds_read_b64_tr_b16 %6, %8 offset:%13\n\t"
                             "ds_read_b64_tr_b16 %7, %8 offset:%14\n\t"
                             "s_waitcnt lgkmcnt(0)"
                             : "=&v"(v000), "=&v"(v001), "=&v"(v010), "=&v"(v011), "=&v"(v100), "=&v"(v101), "=&v"(v110), "=&v"(v111)
                             : "v"(va), "n"(8 * ATT_RS), "n"(16 * ATT_RS), "n"(24 * ATT_RS), "n"(64 + 8 * ATT_RS), "n"(64 + 16 * ATT_RS), "n"(64 + 24 * ATT_RS)
                             : "memory");
                bf16x8 A00, A01, A10, A11;
                A00 = (bf16x8){v000[0], v000[1], v000[2], v000[3], v001[0], v001[1], v001[2], v001[3]};
                A01 = (bf16x8){v010[0], v010[1], v010[2], v010[3], v011[0], v011[1], v011[2], v011[3]};
                A10 = (bf16x8){v100[0], v100[1], v100[2], v100[3], v101[0], v101[1], v101[2], v101[3]};
                A11 = (bf16x8){v110[0], v110[1], v110[2], v110[3], v111[0], v111[1], v111[2], v111[3]};
                O0 = __builtin_amdgcn_mfma_f32_32x32x16_bf16(A00, Pf[0], O0, 0, 0, 0);
                O0 = __builtin_amdgcn_mfma_f32_32x32x16_bf16(A01, Pf[1], O0, 0, 0, 0);
                O1 = __builtin_amdgcn_mfma_f32_32x32x16_bf16(A10, Pf[0], O1, 0, 0, 0);
                O1 = __builtin_amdgcn_mfma_f32_32x32x16_bf16(A11, Pf[1], O1, 0, 0, 0);
            }
            l += __shfl_xor(l, 32);
            const float inv = 1.0f / l;
            bf16_t* op = YM + (size_t)tq * DM + 512 + head * 64 + 4 * hh;
#pragma unroll
            for (int k4 = 0; k4 < 4; ++k4) {
                u32x2 w0, w1;
                w0.x = cvt_pk_bf16(O0[4 * k4 + 0] * inv, O0[4 * k4 + 1] * inv); w0.y = cvt_pk_bf16(O0[4 * k4 + 2] * inv, O0[4 * k4 + 3] * inv);
                w1.x = cvt_pk_bf16(O1[4 * k4 + 0] * inv, O1[4 * k4 + 1] * inv); w1.y = cvt_pk_bf16(O1[4 * k4 + 2] * inv, O1[4 * k4 + 3] * inv);
                *(u32x2*)(op + 8 * k4) = w0; *(u32x2*)(op + 32 + 8 * k4) = w1;
            }
        }
    }
    __syncthreads();
}
constexpr int SGU_RS = 272;
__device__ __forceinline__ void sgu_mfma(Frame& F, const Args& AR, int li) {
    const bf16_t* Z = (const bf16_t*)(F_WS + WS_Z); bf16_t* YM = (bf16_t*)(F_WS + WS_YM); const float* VS = (const float*)(F_WS + WS_VSTAT);
    const bf16_t* WSB = (const bf16_t*)(F_WS + WS_WSB) + (size_t)li * 8 * 16384;
    const float* GN = KIN(9) + (size_t)li * DM; const float* BS = KIN(11) + (size_t)li * 8 * 128;
    constexpr int IMG = 128 * SGU_RS;
    const int tid = F_TID, lane = tid & 63, wave = __builtin_amdgcn_readfirstlane(tid >> 6);
    const int l31 = lane & 31, hh = lane >> 5, gi2 = (lane >> 4) & 1, q4 = (lane & 15) >> 2, p4 = lane & 3;
    const int ct = wave & 3, ia = wave >> 2;
    const int sj = tid >> 2, sc0 = (tid & 3) * 32;
    u32x4 sp[4]; f32x2 sst[4];
#define SGU_LOAD(unit_) do { const int _bn = (unit_) >> 3, _g = (unit_) & 7, _tok = _bn * 128 + sj; \
        const f32x2* _st = (const f32x2*)(VS + (size_t)_tok * 32) + (tid & 3) * 4; \
        _Pragma("unroll") for (int _i = 0; _i < 4; ++_i) sst[_i] = _st[_i]; \
        const u32x4* _p = (const u32x4*)(Z + (size_t)_tok * ZP + 1024 + _g * 128 + sc0); \
        _Pragma("unroll") for (int _k = 0; _k < 4; ++_k) sp[_k] = _p[_k]; } while (0)
#define SGU_STORE(unit_, buf_) do { const int _g = (unit_) & 7; float sm = 0.f, sq = 0.f; \
        _Pragma("unroll") for (int _i = 0; _i < 4; ++_i) { sm += sst[_i].x; sq += sst[_i].y; } \
        sm += __shfl_xor(sm, 1); sm += __shfl_xor(sm, 2); sq += __shfl_xor(sq, 1); sq += __shfl_xor(sq, 2); \
        const float mean = sm * (1.f / DM), rstd = 1.0f / sqrtf(sq * (1.f / DM) - mean * mean + EPS); \
        const f32x4* gp4 = (const f32x4*)(GN + _g * 128 + sc0); \
        _Pragma("unroll") for (int _k = 0; _k < 4; ++_k) { const u32x4 a = sp[_k]; const f32x4 g0 = gp4[2 * _k], g1 = gp4[2 * _k + 1]; u32x4 w; \
            w.x = cvt_pk_bf16((bf_lo(a.x) - mean) * rstd * g0.x, (bf_hi(a.x) - mean) * rstd * g0.y); w.y = cvt_pk_bf16((bf_lo(a.y) - mean) * rstd * g0.z, (bf_hi(a.y) - mean) * rstd * g0.w); \
            w.z = cvt_pk_bf16((bf_lo(a.z) - mean) * rstd * g1.x, (bf_hi(a.z) - mean) * rstd * g1.y); w.w = cvt_pk_bf16((bf_lo(a.w) - mean) * rstd * g1.z, (bf_hi(a.w) - mean) * rstd * g1.w); \
            *(LAS u32x4*)(F.lds + (buf_) * IMG + sj * SGU_RS + sc0 * 2 + 16 * _k) = w; } } while (0)
    __syncthreads();
    int unit = F_BID, par = 0;
    const bool wlds = (F_G % 8 == 0);
    LAS unsigned char* wtile = F.lds + 2 * IMG;
    if (wlds) { const bf16_t* wsrc = WSB + (size_t)(F_BID & 7) * 16384; u32x4 wv[4];
#pragma unroll
        for (int k = 0; k < 4; ++k) wv[k] = *(const u32x4*)(wsrc + (size_t)((tid >> 4) + 32 * k) * 128 + (tid & 15) * 8);
#pragma unroll
        for (int k = 0; k < 4; ++k) *(LAS u32x4*)(wtile + ((tid >> 4) + 32 * k) * SGU_RS + (tid & 15) * 16) = wv[k]; }
    if (unit < 1024) { SGU_LOAD(unit); SGU_STORE(unit, 0); }
    __syncthreads();
    for (; unit < 1024; unit += F_G, par ^= 1) {
        const int nxt = unit + F_G;
        if (nxt < 1024) SGU_LOAD(nxt);
        const int bn = unit >> 3, g = unit & 7, tok0 = bn * 128;
        LAS unsigned char* vimg = F.lds + par * IMG;
        bf16x8 Bf[2][8]; u32x2 uu[2][4]; float bsv[2];
#pragma unroll
        for (int ib = 0; ib < 2; ++ib) {
            const int it = 2 * ia + ib;
            const int ns = 2 * it + 2;
            const bf16_t* wrow = WSB + (size_t)g * 16384 + (size_t)(32 * it + l31) * 128 + 8 * hh;
#pragma unroll
            for (int s2 = 0; s2 < 8; ++s2) if (s2 < ns) { if (wlds) Bf[ib][s2] = *(const LAS bf16x8*)(wtile + (32 * it + l31) * SGU_RS + (16 * s2 + 8 * hh) * 2); else Bf[ib][s2] = *(const bf16x8*)(wrow + 16 * s2); }
            const int i = 32 * it + l31, tok = tok0 + i; bsv[ib] = BS[g * 128 + i];
            const bf16_t* up = Z + (size_t)tok * ZP + g * 128 + 32 * ct + 4 * hh;
#pragma unroll
            for (int k4 = 0; k4 < 4; ++k4) uu[ib][k4] = *(const u32x2*)(up + 8 * k4);
        }
#pragma unroll
        for (int ib = 0; ib < 2; ++ib) {
            const int it = 2 * ia + ib, ns = 2 * it + 2;
            const int i = 32 * it + l31, tok = tok0 + i;
            bf16_t* op = YM + (size_t)tok * DM + g * 128 + 32 * ct + 4 * hh;
            f32x16 C;
#pragma unroll
            for (int q = 0; q < 16; ++q) C[q] = 0.f;
            const unsigned va = (unsigned)(size_t)vimg + (unsigned)((8 * hh + q4) * SGU_RS + (32 * ct + 16 * gi2 + 4 * p4) * 2);
#pragma unroll
            for (int s4 = 0; s4 < 4; ++s4) {
                if (2 * s4 < ns) {
                    s16x4 t0, t1, t2, t3;
                    asm volatile("ds_read_b64_tr_b16 %0, %4\n\tds_read_b64_tr_b16 %1, %4 offset:%5\n\tds_read_b64_tr_b16 %2, %4 offset:%6\n\tds_read_b64_tr_b16 %3, %4 offset:%7\n\ts_waitcnt lgkmcnt(0)"
                                 : "=&v"(t0), "=&v"(t1), "=&v"(t2), "=&v"(t3) : "v"(va + (unsigned)(32 * s4 * SGU_RS)), "n"(4 * SGU_RS), "n"(16 * SGU_RS), "n"(20 * SGU_RS) : "memory");
                    const bf16x8 A0 = (bf16x8){t0[0], t0[1], t0[2], t0[3], t1[0], t1[1], t1[2], t1[3]};
                    const bf16x8 A1 = (bf16x8){t2[0], t2[1], t2[2], t2[3], t3[0], t3[1], t3[2], t3[3]};
                    C = __builtin_amdgcn_mfma_f32_32x32x16_bf16(A0, Bf[ib][2 * s4], C, 0, 0, 0);
                    C = __builtin_amdgcn_mfma_f32_32x32x16_bf16(A1, Bf[ib][2 * s4 + 1], C, 0, 0, 0);
                }
            }
            const float bv = bsv[ib];
#pragma unroll
            for (int k4 = 0; k4 < 4; ++k4) { u32x2 w;
                w.x = cvt_pk_bf16(bf_lo(uu[ib][k4].x) * (C[4 * k4 + 0] + bv), bf_hi(uu[ib][k4].x) * (C[4 * k4 + 1] + bv)); w.y = cvt_pk_bf16(bf_lo(uu[ib][k4].y) * (C[4 * k4 + 2] + bv), bf_hi(uu[ib][k4].y) * (C[4 * k4 + 3] + bv));
                *(u32x2*)(op + 8 * k4) = w; }
        }
        if (nxt < 1024) SGU_STORE(nxt, par ^ 1);
        __syncthreads();
    }
#undef SGU_LOAD
#undef SGU_STORE
}
template <int W>
__device__ __forceinline__ void pool_window(const bf16_t* zp, int t, bf16x8 (&Bf)[8]) {
    const int cntw = (t + 1) < W ? (t + 1) : W; const float inv = 1.0f / (float)cntw;
#pragma unroll
    for (int s2 = 0; s2 < 8; ++s2) {
        u32x4 a[W];
#pragma unroll
        for (int j = 0; j < W; ++j) { const int jj = j < cntw ? j : 0; a[j] = *(const u32x4*)(zp - (size_t)jj * ZP + 16 * s2); }
        float acc[8];
#pragma unroll
        for (int i = 0; i < 8; ++i) acc[i] = 0.f;
#pragma unroll
        for (int j = 0; j < W; ++j) { const float m = j < cntw ? 1.f : 0.f;
            acc[0] += m * bf_lo(a[j].x); acc[1] += m * bf_hi(a[j].x); acc[2] += m * bf_lo(a[j].y); acc[3] += m * bf_hi(a[j].y);
            acc[4] += m * bf_lo(a[j].z); acc[5] += m * bf_hi(a[j].z); acc[6] += m * bf_lo(a[j].w); acc[7] += m * bf_hi(a[j].w); }
        const float s0 = bf_lo(a[0].x), s1 = bf_hi(a[0].x), s2f = bf_lo(a[0].y), s3 = bf_hi(a[0].y), s4 = bf_lo(a[0].z), s5 = bf_hi(a[0].z), s6 = bf_lo(a[0].w), s7 = bf_hi(a[0].w);
        u32x4 pk; pk.x = cvt_pk_bf16(acc[0] * inv - s0, acc[1] * inv - s1); pk.y = cvt_pk_bf16(acc[2] * inv - s2f, acc[3] * inv - s3);
        pk.z = cvt_pk_bf16(acc[4] * inv - s4, acc[5] * inv - s5); pk.w = cvt_pk_bf16(acc[6] * inv - s6, acc[7] * inv - s7);
        Bf[s2] = __builtin_bit_cast(bf16x8, pk);
    }
}
constexpr int POOL_RS = 272;
constexpr int POOL_TILE = 48 * POOL_RS;
template <int W>
__device__ __forceinline__ void pool_window_lds(const bf16_t* Zg, int tok0, int lane, LAS unsigned char* tile, bf16x8 (&Bf)[8]) {
    constexpr int NR = 32 + W - 1, NI = (NR + 3) / 4;
    const int rr = lane >> 4, cc = lane & 15;
    u32x4 st[NI];
#pragma unroll
    for (int i = 0; i < NI; ++i) { const int r = 4 * i + rr; int tk = tok0 - (W - 1) + r; tk = tk < 0 ? 0 : tk; tk = tk > NT - 1 ? NT - 1 : tk;
        st[i] = *(const u32x4*)(Zg + (size_t)tk * ZP + cc * 8); }
#pragma unroll
    for (int i = 0; i < NI; ++i) { const int r = 4 * i + rr; if (r < NR) *(LAS u32x4*)(tile + r * POOL_RS + cc * 16) = st[i]; }
    LDS_WAIT(); asm volatile("" ::: "memory");
    const int l31 = lane & 31, hh = lane >> 5, t = (tok0 + l31) % SEQ;
    const int cntw = (t + 1) < W ? (t + 1) : W; const float inv = 1.0f / (float)cntw;
    const LAS unsigned char* base = tile + (l31 + W - 1) * POOL_RS + hh * 16;
#pragma unroll
    for (int s2 = 0; s2 < 8; ++s2) {
        u32x4 a[W];
#pragma unroll
        for (int j = 0; j < W; ++j) a[j] = *(const LAS u32x4*)(base - j * POOL_RS + 32 * s2);
        float acc[8];
#pragma unroll
        for (int i = 0; i < 8; ++i) acc[i] = 0.f;
#pragma unroll
        for (int j = 0; j < W; ++j) { const float m = j < cntw ? 1.f : 0.f;
            acc[0] += m * bf_lo(a[j].x); acc[1] += m * bf_hi(a[j].x); acc[2] += m * bf_lo(a[j].y); acc[3] += m * bf_hi(a[j].y);
            acc[4] += m * bf_lo(a[j].z); acc[5] += m * bf_hi(a[j].z); acc[6] += m * bf_lo(a[j].w); acc[7] += m * bf_hi(a[j].w); }
        const float s0 = bf_lo(a[0].x), s1 = bf_hi(a[0].x), s2f = bf_lo(a[0].y), s3 = bf_hi(a[0].y), s4 = bf_lo(a[0].z), s5 = bf_hi(a[0].z), s6 = bf_lo(a[0].w), s7 = bf_hi(a[0].w);
        u32x4 pk; pk.x = cvt_pk_bf16(acc[0] * inv - s0, acc[1] * inv - s1); pk.y = cvt_pk_bf16(acc[2] * inv - s2f, acc[3] * inv - s3);
        pk.z = cvt_pk_bf16(acc[4] * inv - s4, acc[5] * inv - s5); pk.w = cvt_pk_bf16(acc[6] * inv - s6, acc[7] * inv - s7);
        Bf[s2] = __builtin_bit_cast(bf16x8, pk);
    }
}
__device__ __forceinline__ void pool_mfma(Frame& F, const Args& AR, int li) {
    const bf16_t* Z = (const bf16_t*)(F_WS + WS_Z); bf16_t* YM = (bf16_t*)(F_WS + WS_YM);
    const bf16_t* PWT = (const bf16_t*)(F_WS + WS_PWT) + (size_t)li * 4 * 16384; const float* PS = KIN(7) + (size_t)li * 512;
    const int lane = F_LANE, l31 = lane & 31, hh = lane >> 5;
    const int NJOB = 2048, W0 = F_BID * NWAVES + F_WAVE, NW = F_G * NWAVES;
    for (int job = W0; job < NJOB; job += NW) {
        const int g = job & 3, tile = job >> 2;
        const int tok = tile * 32 + l31, t = tok % SEQ;
        bf16x8 Bf[8];
        const bf16_t* Zg = Z + g * 128; LAS unsigned char* ptile = F.lds + F_WAVE * POOL_TILE;
        switch (__builtin_amdgcn_readfirstlane(g)) {
            case 0: pool_window_lds<2>(Zg, tile * 32, lane, ptile, Bf); break;
            case 1: pool_window_lds<4>(Zg, tile * 32, lane, ptile, Bf); break;
            case 2: pool_window_lds<8>(Zg, tile * 32, lane, ptile, Bf); break;
            default: pool_window_lds<16>(Zg, tile * 32, lane, ptile, Bf); break;
        }
#pragma unroll
        for (int dt = 0; dt < 4; ++dt) {
            f32x16 C;
#pragma unroll
            for (int i = 0; i < 16; ++i) C[i] = 0.f;
            const bf16_t* arow = PWT + (size_t)g * 16384 + (size_t)(32 * dt + l31) * 128 + 8 * hh;
#pragma unroll
            for (int s2 = 0; s2 < 8; ++s2) { const bf16x8 Af = *(const bf16x8*)(arow + 16 * s2); C = __builtin_amdgcn_mfma_f32_32x32x16_bf16(Af, Bf[s2], C, 0, 0, 0); }
            bf16_t* op = YM + (size_t)tok * DM + g * 128 + 32 * dt + 4 * hh; const float* ps = PS + g * 128 + 32 * dt + 4 * hh;
#pragma unroll
            for (int k4 = 0; k4 < 4; ++k4) { const f32x4 sc = *(const f32x4*)(ps + 8 * k4); u32x2 wv;
                wv.x = cvt_pk_bf16(C[4 * k4 + 0] * sc.x, C[4 * k4 + 1] * sc.y); wv.y = cvt_pk_bf16(C[4 * k4 + 2] * sc.z, C[4 * k4 + 3] * sc.w);
                *(u32x2*)(op + 8 * k4) = wv; }
        }
    }
}
typedef float f32x4v __attribute__((ext_vector_type(4)));
__device__ __forceinline__ void router_mfma(Frame& F, const Args& AR, int layer) {
    const bf16_t* WRH = (const bf16_t*)(F_WS + WS_WRT) + (size_t)layer * 80 * 1024; const bf16_t* WRL = WRH + NL * 80 * 1024; const bf16_t* XBp = (const bf16_t*)(F_WS + WS_XB);
    const float* GB = KIN(14) + layer * 8; const float* EB = KIN(16) + layer * 64; const float* gn = KIN(2) + (size_t)layer * DM;
    i32x4* list = (i32x4*)(F_WS + WS_LIST); i32x4* tinfo = (i32x4*)(F_WS + WS_TOKINFO);
    unsigned* cnt = F_CTL + CW_CNT + layer * NE * 64;
    LAS float* part = (LAS float*)(F.lds);
    LAS float* lg = (LAS float*)(F.lds + 90112);
    LAS float* rs = (LAS float*)(F.lds + 90112 + 20992);
    LAS unsigned* lcnt = (LAS unsigned*)(F.lds + 90112 + 20992 + 256);
    const int lane = F_LANE, a_tok = lane & 15, kq = lane >> 4, w = F_WAVE;
    for (int unit = F_BID; unit < NT / 64; unit += F_G) {
        const int tokb = unit * 64;
        f32x4 acc[4][5]; float ss[4];
#pragma unroll
        for (int t = 0; t < 4; ++t) { ss[t] = 0.f;
#pragma unroll
            for (int nt = 0; nt < 5; ++nt) acc[t][nt] = (f32x4){0.f, 0.f, 0.f, 0.f}; }
        const unsigned woff = (unsigned)((a_tok * 1024 + w * 128 + 8 * kq) * 2), xoff = (unsigned)(((tokb + a_tok) * DM + w * 128 + 8 * kq) * 2);
        const GAS char* whb[5]; const GAS char* wlb[5]; const GAS char* xb = (const GAS char*)XBp;
#pragma unroll
        for (int nt = 0; nt < 5; ++nt) { whb[nt] = (const GAS char*)WRH + nt * 32768; wlb[nt] = (const GAS char*)WRL + nt * 32768; asm volatile("" : "+s"(whb[nt]), "+s"(wlb[nt])); }
        bf16x8 wh[2][5], wl[2][5]; u32x4 xv[2][4];
#define R_LOAD(b, j) { _Pragma("unroll") for (int nt = 0; nt < 5; ++nt) { wh[b][nt] = *(const GAS bf16x8*)(whb[nt] + 64 * (j) + woff); wl[b][nt] = *(const GAS bf16x8*)(wlb[nt] + 64 * (j) + woff); } \
                       _Pragma("unroll") for (int t = 0; t < 4; ++t) xv[b][t] = *(const GAS u32x4*)(xb + (t * 16 * DM * 2 + 64 * (j)) + xoff); }
#define R_COMP(b) { _Pragma("unroll") for (int t = 0; t < 4; ++t) { const u32x4 xr4 = xv[b][t]; \
                { const float x0 = bf_lo(xr4.x), x1 = bf_hi(xr4.x), x2 = bf_lo(xr4.y), x3 = bf_hi(xr4.y), x4 = bf_lo(xr4.z), x5 = bf_hi(xr4.z), x6 = bf_lo(xr4.w), x7 = bf_hi(xr4.w); \
                  ss[t] += ((x0 * x0 + x1 * x1) + (x2 * x2 + x3 * x3)) + ((x4 * x4 + x5 * x5) + (x6 * x6 + x7 * x7)); } \
                const bf16x8 xa = __builtin_bit_cast(bf16x8, xr4); \
                _Pragma("unroll") for (int nt = 0; nt < 5; ++nt) { acc[t][nt] = __builtin_amdgcn_mfma_f32_16x16x32_bf16(xa, wh[b][nt], acc[t][nt], 0, 0, 0); acc[t][nt] = __builtin_amdgcn_mfma_f32_16x16x32_bf16(xa, wl[b][nt], acc[t][nt], 0, 0, 0); } } }
        R_LOAD(0, 0); R_LOAD(1, 1); __builtin_amdgcn_sched_barrier(0);
        R_COMP(0); __builtin_amdgcn_sched_barrier(0); R_LOAD(0, 2); __builtin_amdgcn_sched_barrier(0);
        R_COMP(1); __builtin_amdgcn_sched_barrier(0); R_LOAD(1, 3); __builtin_amdgcn_sched_barrier(0);
        R_COMP(0); R_COMP(1);
#undef R_LOAD
#undef R_COMP
#pragma unroll
        for (int t = 0; t < 4; ++t) { ss[t] += __shfl_xor(ss[t], 16); ss[t] += __shfl_xor(ss[t], 32); }
#pragma unroll
        for (int half = 4; half >= 1; half >>= 1) {
            __syncthreads();
            if (w >= half && w < 2 * half) { LAS f32x4* p = (LAS f32x4*)part + (size_t)(w - half) * (21 * 64) + lane;
#pragma unroll
                for (int t = 0; t < 4; ++t) {
#pragma unroll
                    for (int nt = 0; nt < 5; ++nt) p[(t * 5 + nt) * 64] = acc[t][nt]; }
                p[20 * 64] = (f32x4){ss[0], ss[1], ss[2], ss[3]}; }
            __syncthreads();
            if (w < half) { const LAS f32x4* p = (const LAS f32x4*)part + (size_t)w * (21 * 64) + lane;
#pragma unroll
                for (int t = 0; t < 4; ++t) {
#pragma unroll
                    for (int nt = 0; nt < 5; ++nt) acc[t][nt] += p[(t * 5 + nt) * 64]; }
                const f32x4 s4 = p[20 * 64]; ss[0] += s4.x; ss[1] += s4.y; ss[2] += s4.z; ss[3] += s4.w; }
        }
        if (w == 0) {
            const int l2 = F_LANE, a2 = l2 & 15, k2 = l2 >> 4;
#pragma unroll
            for (int t = 0; t < 4; ++t) { const float rstd = 1.0f / sqrtf(ss[t] * (1.f / DM) + EPS); if (k2 == 0) rs[t * 16 + a2] = rstd; }
            LDS_WAIT(); asm volatile("" ::: "memory");
            LAS float* lgb = lg + k2 * 324 + a2; const LAS float* rsb = rs + 4 * k2;
#pragma unroll
            for (int nt = 0; nt < 5; ++nt) { const int n = 16 * nt + a2; const float bias = n < 8 ? GB[n] : (n < 72 ? EB[n - 8] : 0.f);
#pragma unroll
                for (int t = 0; t < 4; ++t) {
#pragma unroll
                    for (int rg = 0; rg < 4; ++rg) lgb[(t * 16 + rg) * 81 + 16 * nt] = acc[t][nt][rg] * rsb[t * 16 + rg] + bias; } }
        }
        __syncthreads();
        int x1 = 0, x2 = 0; unsigned r1 = 0, r2 = 0; float g1 = 0.f, g2 = 0.f;
        if (F_TID < 64) lcnt[F_TID] = 0u;
        __syncthreads();
        if (F_TID < 64) {
            const LAS float* L = lg + F_TID * 81;
            float m = L[0]; int gi = 0;
            for (int i = 1; i < 8; ++i) if (L[i] > m) { m = L[i]; gi = i; }
            float s = 0.f; for (int i = 0; i < 8; ++i) s += __expf(L[i] - m);
            const float gp = 1.0f / s;
            const LAS float* E = L + 8 + gi * 8;
            float t1 = E[0]; int i1 = 0;
            for (int i = 1; i < 8; ++i) if (E[i] > t1) { t1 = E[i]; i1 = i; }
            float t2 = -INFINITY; int i2 = 0;
            for (int i = 0; i < 8; ++i) if (i != i1 && E[i] > t2) { t2 = E[i]; i2 = i; }
            const float e2 = __expf(t2 - t1); const float p1 = 1.0f / (1.0f + e2), p2 = e2 / (1.0f + e2);
            x1 = gi * 8 + i1; x2 = gi * 8 + i2; g1 = gp * p1; g2 = gp * p2;
            r1 = __hip_atomic_fetch_add(lcnt + x1, 1u, __ATOMIC_RELAXED, __HIP_MEMORY_SCOPE_WORKGROUP);
            r2 = __hip_atomic_fetch_add(lcnt + x2, 1u, __ATOMIC_RELAXED, __HIP_MEMORY_SCOPE_WORKGROUP);
        }
        __syncthreads();
        if (F_TID < 64) { const unsigned c = lcnt[F_TID]; unsigned base = 0u;
            if (c) base = __hip_atomic_fetch_add(cnt + F_TID * 64, c, __ATOMIC_RELAXED, __HIP_MEMORY_SCOPE_AGENT);
            lcnt[F_TID] = base; }
        __syncthreads();
        if (F_TID < 64) {
            const int tok = tokb + F_TID; const int pos1 = (int)(lcnt[x1] + r1), pos2 = (int)(lcnt[x2] + r2);
            const int rsi = __float_as_int(rs[F_TID]);
            list[(size_t)x1 * NT + pos1] = (i32x4){tok, __float_as_int(g1), rsi, 0};
            list[(size_t)x2 * NT + pos2] = (i32x4){tok, __float_as_int(g2), rsi, 0};
            tinfo[tok] = (i32x4){x1, pos1, x2, pos2};
        }
    }
    __syncthreads();
}
__device__ __forceinline__ void combine_phase(Frame& F, const Args& AR, int layer, bool have_seg) {
    const MoeTabs T = moe_tabs(F);
    if (!have_seg) moe_build_seg(F, AR, T, layer);
    const bf16_t* Y = (const bf16_t*)(F_WS + WS_YMOE); const i32x4* tinfo = (const i32x4*)(F_WS + WS_TOKINFO);
    const bool lastl = (layer == NL - 1);
    const float* gn = lastl ? KIN(3) : KIN(1) + (size_t)(layer + 1) * DM;
    const int gw = F_BID * NWAVES + F_WAVE, NGW = F_G * NWAVES;
    for (int m0 = gw; m0 < NT; m0 += 2 * NGW) {
        const int m1 = m0 + NGW; const bool two = m1 < NT;
        const i32x4 ti0 = tinfo[m0]; i32x4 ti1 = ti0; if (two) ti1 = tinfo[m1];
        u32x2 ya[2][4], yb[2][4], xv[2][4];
#pragma unroll
        for (int q = 0; q < 2; ++q) {
            const i32x4 ti = q ? ti1 : ti0; const int m = q ? (two ? m1 : m0) : m0;
            const int ra = T.seg[ti.x] + ti.y, rb = T.seg[ti.z] + ti.w;
            const u32x2* xi = (const u32x2*)((const bf16_t*)(F_WS + WS_XB) + (size_t)m * DM) + F_LANE; const u32x2* pa = (const u32x2*)(Y + (size_t)ra * DM) + F_LANE; const u32x2* pb = (const u32x2*)(Y + (size_t)rb * DM) + F_LANE;
#pragma unroll
            for (int j = 0; j < 4; ++j) { ya[q][j] = pa[64 * j]; yb[q][j] = pb[64 * j]; xv[q][j] = xi[64 * j]; }
        }
#pragma unroll
        for (int q = 0; q < 2; ++q) {
            if (q == 1 && !two) break;
            const int m = q ? m1 : m0;
            u32x2* xr = (u32x2*)((bf16_t*)(F_WS + WS_X16) + (size_t)m * DM) + F_LANE;
            f32x4 v[4];
#pragma unroll
            for (int j = 0; j < 4; ++j) { const u32x2 a = ya[q][j], b = yb[q][j]; const u32x2 xx = xv[q][j]; f32x4 x = (f32x4){bf_lo(xx.x), bf_hi(xx.x), bf_lo(xx.y), bf_hi(xx.y)};
#ifndef DBG_NO_MOE
                x.x += bf_lo(a.x) + bf_lo(b.x); x.y += bf_hi(a.x) + bf_hi(b.x); x.z += bf_lo(a.y) + bf_lo(b.y); x.w += bf_hi(a.y) + bf_hi(b.y);
#endif
                v[j] = x; }
            if (lastl) norm_row(v, gn, F_LANE, nullptr, F_X + (size_t)m * DM);
            else {
#pragma unroll
                for (int j = 0; j < 4; ++j) { u32x2 w; w.x = cvt_pk_bf16(v[j].x, v[j].y); w.y = cvt_pk_bf16(v[j].z, v[j].w); xr[64 * j] = w; }
                row_rstd(v, F_LANE, (float*)(F_WS + WS_RSTD) + m);
            }
        }
    }
}

constexpr int NPH = 1 + NL * 7;
#ifndef PH_MASK
#define PH_MASK 0xFF
#endif
#define EN(b) (((PH_MASK) >> (b)) & 1)
#ifndef REP_MASK
#define REP_MASK 0
#endif
#define REPS(b) (1 + (((REP_MASK) >> (b)) & 1))
#define IN(k) (AR.ph_lo <= (k) && (k) < AR.ph_hi)
#define SEAM(k) do { if (IN((k) + 1)) { XcdBarrier _b; _b.bar = F_CTL + CW_BAR; _b.x = xb_xcc_id(); _b.st = (volatile LAS unsigned*)(F.lds + MISC_OFF + MO_BAR); xcd_barrier(_b); } } while (0)

template <int layer>
__device__ __forceinline__ void layer_phases(Frame& F, const Args& AR) {
    constexpr int pb = 1 + layer * 7; constexpr int li = layer >> 1; constexpr bool odd = (layer & 1) != 0;
    if (EN(0) && IN(pb + 0)) {
        pg8::PlainSched S; S.init(F_WS + WS_X16, F_WS + WS_WIN + (size_t)layer * 2048 * DM * 2, NT, 2048, DM, F_G, F_BID);
        pg8::EpiZ<odd> E{(bf16_t*)(F_WS + WS_Z), (float*)(F_WS + WS_VSTAT), (const float*)(F_WS + WS_RSTD)}; for (int rep = 0; rep < REPS(0); ++rep) pg8::gemm_phase<pg8::EpiZ<odd>, pg8::PlainSched, true>(F.lds, DM, S, E);
        SEAM(pb + 0);
    }
    if (EN(1) && IN(pb + 1)) {
        for (int rep = 0; rep < REPS(1); ++rep) { if (!odd) { for (int r2 = 0; r2 < REPS(8); ++r2) attn_mfma(F, AR); for (int r2 = 0; r2 < REPS(9); ++r2) pool_mfma(F, AR, li); } else { for (int r2 = 0; r2 < REPS(10); ++r2) sgu_mfma(F, AR, li); } }
        SEAM(pb + 1);
    }
    if (EN(2) && IN(pb + 2)) {
        pg8::PlainSched S; S.init(F_WS + WS_YM, F_WS + WS_WOUT + (size_t)layer * DM * DM * 2, NT, DM, DM, F_G, F_BID);
        pg8::EpiResid E{(const bf16_t*)(F_WS + WS_X16), (bf16_t*)(F_WS + WS_XB)}; for (int rep = 0; rep < REPS(2); ++rep) pg8::gemm_phase<pg8::EpiResid, pg8::PlainSched, false>(F.lds, DM, S, E);
        SEAM(pb + 2);
    }
    if (EN(3) && IN(pb + 3)) { router_mfma(F, AR, layer); SEAM(pb + 3); }
    if (EN(4) && IN(pb + 4)) {
        const MoeTabs T = moe_tabs(F);
        moe_build_seg(F, AR, T, layer);
        const int nfull = __builtin_amdgcn_readfirstlane(T.fst[NE]), total = nfull + __builtin_amdgcn_readfirstlane(T.hst[NE]);
        const bool fusedM = EN(5) && IN(pb + 5) && moe_fusable(nfull, total, F_G);
        for (int rep = 0; rep < REPS(4); ++rep)
        for (int base = 0; base < total; base += MAXU * F_G) {
            int nfw; const int nu = moe_build_units(F, AR, T, layer, base, true, nfull, total, false, nfw);
            pg4::gemm4_phase<0, 32, DE>(F.lds, T.tab, T.toks, T.rstd, (const char*)(F_WS + WS_XB), KIN(17), KIN(18), KIN(2) + (size_t)layer * DM, (bf16_t*)(F_WS + WS_HMOE), layer, nu);
            __syncthreads();
            if (fusedM && rep == 0) moe_publish(F, AR, T, layer, nu);
        }
        if (!fusedM) SEAM(pb + 4);
    }
    if (EN(5) && IN(pb + 5)) {
        const MoeTabs T = moe_tabs(F);
        const bool have = EN(4) && IN(pb + 4);
        if (!have) moe_build_seg(F, AR, T, layer);
        const int nfull = __builtin_amdgcn_readfirstlane(T.fst[NE]), total = nfull + __builtin_amdgcn_readfirstlane(T.hst[NE]);
        const bool fusedM = have && moe_fusable(nfull, total, F_G);
        const bool reuse = have && !fusedM && total <= MAXU * F_G;
        for (int rep = 0; rep < REPS(5); ++rep)
        for (int base = 0; base < total; base += MAXU * F_G) {
            int nfw; const int nu = moe_build_units(F, AR, T, layer, base, !reuse && !fusedM, nfull, total, fusedM, nfw);
            if (!fusedM) nfw = nu;
#pragma nounroll
            for (int part = 0; part < 2; ++part) { const int s0 = part ? nfw : 0, s1 = part ? nu : nfw;
                if (s1 > s0) {
                    if (fusedM && part) { int dummy; (void)moe_build_units(F, AR, T, layer, base, true, nfull, total, true, dummy, nfw); }
                    if (fusedM) moe_wait(F, AR, T, layer, s0, s1);
                    pg4::gemm4_phase<1, 16, DM>(F.lds, T.tab + s0 * 8, T.toks + s0 * 256, T.gates + s0 * 256, (const char*)(F_WS + WS_HMOE), KIN(19), KIN(19), nullptr, (bf16_t*)(F_WS + WS_YMOE), layer, s1 - s0);
                    __syncthreads(); } }
        }
        SEAM(pb + 5);
    }
        if (EN(6) && IN(pb + 6)) { for (int rep = 0; rep < REPS(6); ++rep) combine_phase(F, AR, layer, (EN(4) && IN(pb + 4)) || (EN(5) && IN(pb + 5)));
    if (layer + 1 < NL) SEAM(pb + 6); }
}

__global__ void __launch_bounds__(NTHR, 2) fwd_kernel(Args AR) {
    extern __shared__ __attribute__((aligned(16))) unsigned char lds_raw[];
    Frame F;
    F.lds = (LAS unsigned char*)lds_raw;
    for (int u = F_TID; u < (LDS_BYTES - MISC_OFF) / 4; u += NTHR) ((LAS unsigned*)(F.lds + MISC_OFF))[u] = 0u;
    __syncthreads();
    if (AR.ph_hi - AR.ph_lo > 1) (void)xcd_barrier_post(F_CTL + CW_BAR, (volatile LAS unsigned*)(F.lds + MISC_OFF + MO_BAR));

    if (EN(7) && IN(0)) { for (int rep = 0; rep < REPS(7); ++rep) p0_prologue(F, AR); SEAM(0); }
    layer_phases<0>(F, AR);
    layer_phases<1>(F, AR);
    layer_phases<2>(F, AR);
    layer_phases<3>(F, AR);
}
#undef IN
#undef SEAM

extern "C" void kernel_launch(void* const* d_in, const int* in_sizes, int n_in, void* d_out, int out_size, void* d_ws, size_t ws_size, hipStream_t stream) {
    static int grid = 0;
    if (grid == 0) {
        if (n_in != 20 || out_size != NT * DM || ws_size < WS_END) { fprintf(stderr, "kernel_launch: unexpected problem (n_in %d out %d ws %zu)\n", n_in, out_size, ws_size); grid = -1; return; }
        int dev = 0, cus = 0, per_cu = 0;
        if (hipGetDevice(&dev) != hipSuccess || hipDeviceGetAttribute(&cus, hipDeviceAttributeMultiprocessorCount, dev) != hipSuccess) { grid = -1; return; }
        if (hipFuncSetAttribute((const void*)fwd_kernel, hipFuncAttributeMaxDynamicSharedMemorySize, LDS_BYTES) != hipSuccess) { fprintf(stderr, "kernel_launch: hipFuncSetAttribute failed\n"); grid = -1; return; }
        if (hipOccupancyMaxActiveBlocksPerMultiprocessor(&per_cu, (const void*)fwd_kernel, NTHR, LDS_BYTES) != hipSuccess || per_cu < 1) fprintf(stderr, "kernel_launch: occupancy query says %d\n", per_cu);
        (void)hipGetLastError();
        grid = cus;
    }
    if (grid < 0) return;
    (void)hipMemsetAsync((char*)d_ws + WS_CTL, 0, CTL_ZERO_BYTES, stream);
    Args a{};
    for (int i = 0; i < 20; ++i) a.in[i] = (const float*)d_in[i];
    a.out = (float*)d_out; a.ws = (unsigned char*)d_ws;
#if MK_ONE_LAUNCH
    a.ph_lo = 0; a.ph_hi = NPH;
    hipLaunchKernelGGL(fwd_kernel, dim3(grid), dim3(NTHR), LDS_BYTES, stream, a);
#else
    for (int p = 0; p < NPH; ++p) { a.ph_lo = p; a.ph_hi = p + 1; hipLaunchKernelGGL(fwd_kernel, dim3(grid), dim3(NTHR), LDS_BYTES, stream, a); }
#endif
}
```

```cpp
#include <hip/hip_runtime.h>
#include <cstdio>
#include <cstdint>

#ifndef MK_ONE_LAUNCH
#define MK_ONE_LAUNCH 1
#endif

#define LAS __attribute__((address_space(3)))
#define GAS __attribute__((address_space(1)))
typedef unsigned short bf16_t;
typedef short bf16x8 __attribute__((ext_vector_type(8)));
typedef float f32x4 __attribute__((ext_vector_type(4)));
typedef float f32x2 __attribute__((ext_vector_type(2)));
typedef unsigned u32x4 __attribute__((ext_vector_type(4)));
typedef unsigned u32x2 __attribute__((ext_vector_type(2)));
typedef int i32x4 __attribute__((ext_vector_type(4)));
typedef int i32x2 __attribute__((ext_vector_type(2)));

constexpr int NT = 16384, DM = 1024, SEQ = 2048, NL = 4, NE = 64, DE = 512;
constexpr int NWAVES = 8, NTHR = 512;
constexpr float EPS = 1e-6f;
constexpr int ZP = 2048 + 64;
constexpr int ZERO_ROW = NT;
constexpr int NR_ALLOC = 42496;

constexpr size_t MiB = 1u << 20;
constexpr size_t WS_CTL = 0, CTL_ZERO_BYTES = 1 * MiB;
constexpr size_t WS_WSB = 1 * MiB;
constexpr size_t WS_PWT = 1 * MiB + 512 * 1024;
constexpr size_t WS_WIN = 2 * MiB;
constexpr size_t WS_WOUT = 18 * MiB;
constexpr size_t WS_Z = 292 * MiB;
constexpr size_t WS_YM = 123 * MiB;
constexpr size_t WS_VSTAT = 155 * MiB;
constexpr size_t WS_LIST = 400 * MiB;
constexpr size_t WS_TOKINFO = 165 * MiB;
constexpr size_t WS_RSTD = 165 * MiB + 512 * 1024;
constexpr size_t WS_HMOE = 166 * MiB;
constexpr size_t WS_YMOE = 208 * MiB;
constexpr size_t WS_XB = 420 * MiB;
constexpr size_t WS_X16 = 1092 * MiB;
constexpr size_t WS_WRT = 1124 * MiB;
constexpr size_t WS_END = 1126 * MiB;
constexpr int CW_TMO = 0, CW_BAR = 4096, CW_CNT = 8192  , CW_DBG = 40960, CW_BLK = 65536  ;

constexpr int RING_BYTES = 147456;
constexpr int MISC_OFF = RING_BYTES;
constexpr int LDS_BYTES = 161792;
constexpr int MO_BAR = 0;
constexpr int MO_CNT = 64;
constexpr int MO_SEG = MO_CNT + 256;
constexpr int MO_FST = MO_SEG + 272;
constexpr int MO_HST = MO_FST + 272;
constexpr int MAXU = 4;
constexpr int MO_TAB = MO_HST + 272;
constexpr int MO_NMY = MO_TAB + MAXU * 32;
constexpr int MO_TOKS = 2048;
constexpr int MO_GATES = 2048 + 4096;
static_assert(MO_NMY + 4 * MAXU <= MO_TOKS, "misc map");
constexpr int MO_RSTD = MO_GATES + 4096;
static_assert(MISC_OFF + MO_RSTD + MAXU * 1024 <= LDS_BYTES, "misc map 2");

__device__ __forceinline__ unsigned cvt_pk_bf16(float lo, float hi) { unsigned r; asm volatile("v_cvt_pk_bf16_f32 %0, %1, %2" : "=v"(r) : "v"(lo), "v"(hi)); return r; }
__device__ __forceinline__ float bf_lo(unsigned u) { return __builtin_bit_cast(float, u << 16); }
__device__ __forceinline__ float bf_hi(unsigned u) { return __builtin_bit_cast(float, u & 0xffff0000u); }
__device__ __forceinline__ float wave_sum(float v) {
#pragma unroll
    for (int o = 1; o < 64; o <<= 1) v += __shfl_xor(v, o);
    return v;
}
__device__ __forceinline__ float wave_max(float v) {
#pragma unroll
    for (int o = 1; o < 64; o <<= 1) v = fmaxf(v, __shfl_xor(v, o));
    return v;
}
__device__ __forceinline__ float gelu_tanh(float x) {
    const float u = 0.7978845608028654f * (x + 0.044715f * x * x * x);
    const float e = __builtin_amdgcn_exp2f(-2.0f * 1.4426950408889634f * u);
    return x * __builtin_amdgcn_rcpf(1.0f + e);
}
__device__ __forceinline__ float silu_f(float x) {
    const float e = __builtin_amdgcn_exp2f(-1.4426950408889634f * x);
    return x * __builtin_amdgcn_rcpf(1.0f + e);
}
__device__ __forceinline__ int opaque_tid() { int t = (int)threadIdx.x; asm volatile("" : "+v"(t)); return t; }
#define LDS_WAIT() asm volatile("s_waitcnt lgkmcnt(0)" ::: "memory")
#define VM_WAIT() asm volatile("s_waitcnt vmcnt(0)" ::: "memory")

#define XB_TMO      128
#define XB_XCNT(j)  (256  + 64 * (j))
#define XB_XSUB(j)  (1280 + 64 * (j))
#define XB_XGEN(j)  (2304 + 64 * (j))
#define XB_TOP      3328
#define XB_TOPGEN   3392
#define XCD_BAR_WORDS 3456
#define XB_SPIN_CAP (1u << 20)

__device__ __forceinline__ unsigned xb_ld(unsigned* p)              { return __hip_atomic_load(p, __ATOMIC_RELAXED, __HIP_MEMORY_SCOPE_AGENT); }
__device__ __forceinline__ unsigned xb_add(unsigned* p, unsigned v) { return __hip_atomic_fetch_add(p, v, __ATOMIC_RELAXED, __HIP_MEMORY_SCOPE_AGENT); }
__device__ __forceinline__ unsigned xb_xcc_id() { return (unsigned)__builtin_amdgcn_s_getreg((3 << 11) | 20) & 0xFu; }
#define XB_SPIN(cond, bar) do { unsigned _sp = 0; while (cond) { __builtin_amdgcn_s_sleep(1); \
    if ((++_sp & 255u) == 0u) { if (xb_ld(&(bar)[XB_TMO])) break; if (_sp > XB_SPIN_CAP) { atomicAdd(&(bar)[XB_TMO], 1u); break; } } } } while (0)

struct XcdBarrier { unsigned* bar; unsigned x; volatile LAS unsigned* st; };

__device__ __forceinline__ XcdBarrier xcd_barrier_post(unsigned* bar, volatile LAS unsigned* st) {
    XcdBarrier b; b.bar = bar; b.x = xb_xcc_id(); b.st = st;
    if (threadIdx.x == 0) (void)xb_add(&bar[XB_XCNT(b.x)], 1u);
    return b;
}
__device__ __forceinline__ void xcd_barrier_complete(unsigned* bar, unsigned x, unsigned& nloc, unsigned& nx) {
    const unsigned G = gridDim.x * gridDim.y * gridDim.z;
    unsigned sum, cnt, mine, sp = 0u;
    for (;;) {
        sum = 0u; cnt = 0u; mine = 0u;
#pragma unroll
        for (unsigned j = 0; j < 16; ++j) { const unsigned c = xb_ld(&bar[XB_XCNT(j)]); sum += c; cnt += (c > 0u) ? 1u : 0u; mine = (j == x) ? c : mine; }
        if (sum == G) break;
        __builtin_amdgcn_s_sleep(1);
        if ((++sp & 255u) == 0u) { if (xb_ld(&bar[XB_TMO])) break; if (sp > XB_SPIN_CAP) { atomicAdd(&bar[XB_TMO], 1u); break; } }
    }
    nloc = mine > 0u ? mine : 1u; nx = cnt > 0u ? cnt : 1u;
}
__device__ __forceinline__ void xcd_barrier(const XcdBarrier& b) {
    asm volatile("s_waitcnt vmcnt(0)" ::: "memory");
    __syncthreads();
    if (threadIdx.x == 0) {
        unsigned* bar = b.bar;
        __builtin_amdgcn_s_waitcnt(0);
        unsigned nloc = b.st[0], nx = b.st[1];
        if (nloc == 0u) { xcd_barrier_complete(bar, b.x, nloc, nx); b.st[0] = nloc; b.st[1] = nx; }
        const unsigned old = xb_add(&bar[XB_XSUB(b.x)], 1u);
        const unsigned gen = old / nloc;
        if (old + 1u == (gen + 1u) * nloc) {
            __builtin_amdgcn_fence(__ATOMIC_RELEASE, "agent");
            asm volatile("s_waitcnt vmcnt(0)" ::: "memory");
            const unsigned og = xb_add(&bar[XB_TOP], 1u);
            const unsigned tg = og / nx;
            if (og + 1u == (tg + 1u) * nx) xb_add(&bar[XB_TOPGEN], 1u);
            else XB_SPIN(xb_ld(&bar[XB_TOPGEN]) == tg, bar);
            __builtin_amdgcn_fence(__ATOMIC_ACQUIRE, "agent");
            xb_add(&bar[XB_XGEN(b.x)], 1u);
            asm volatile("s_waitcnt vmcnt(0)" ::: "memory");
        } else {
            XB_SPIN(xb_ld(&bar[XB_XGEN(b.x)]) == gen, bar);
            __builtin_amdgcn_fence(__ATOMIC_ACQUIRE, "agent");
            asm volatile("s_waitcnt vmcnt(0)" ::: "memory");
        }
    }
    __syncthreads();
}

namespace pg8 {
constexpr int BM = 256, BK = 64, HALF = 128, HTB = HALF * BK * 2, STAGE_BYTES = 8 * HTB, NXCD = 8, WGM = 8;
__host__ __device__ __forceinline__ int lds_byte(int r, int c) { const int st = (r >> 4) * 2 + (c >> 5), rr = r & 15, cc = c & 31, ob = rr * 64 + cc * 2; return st * 1024 + (ob ^ (((ob >> 9) & 1) << 5)); }
__host__ __device__ __forceinline__ void stage_rc(int b, int& R, int& C) { const int st = b / 1024, sb = b % 1024, swz = sb ^ (((sb >> 9) & 1) << 5); R = (st >> 1) * 16 + swz / 64; C = (st & 1) * 32 + (swz % 64) / 2; }
__host__ __device__ __forceinline__ int perm32(int rho) { const int n = rho >> 4, i = rho & 15; return 8 * (i >> 2) + 4 * n + (i & 3); }

struct Unit { const char* A; const char* B; int rowbase; int pn; int nvalid; int slot; };

struct PlainSched {
    static constexpr bool ALWAYS_FULL = true;
    const char* A; const char* Bt; int K; int nM, nN, nwg, G, c;
    __device__ __forceinline__ void init(const void* A_, const void* Bt_, int M, int N, int K_, int G_, int c_) { A = (const char*)A_; Bt = (const char*)Bt_; K = K_; nM = M / BM; nN = N / BM; nwg = nM * nN; G = G_; c = c_; }
    __device__ __forceinline__ bool next(int i, Unit& u) const {
        const long L = (long)i * G + c; if (L >= nwg) return false;
        int wgid = (int)L; { const int q = nwg / NXCD, r = nwg % NXCD, xcd = wgid % NXCD, off = wgid / NXCD; wgid = (xcd < r ? xcd * (q + 1) : r * (q + 1) + (xcd - r) * q) + off; }
        const int nig = WGM * nN, gid = wgid / nig, fm = gid * WGM, gsz = (nM - fm) < WGM ? (nM - fm) : WGM;
        const int pm = fm + ((wgid % nig) % gsz), pn = (wgid % nig) / gsz;
        u.A = A + (size_t)pm * BM * K * 2; u.B = Bt + (size_t)pn * BM * K * 2; u.rowbase = pm * BM; u.pn = pn; u.nvalid = 256; u.slot = 0; return true;
    }
    __device__ __forceinline__ void aoff(const Unit& u, const int (&R)[2], const int (&C)[2], unsigned (&vo)[2][2]) const {
#pragma unroll
        for (int h = 0; h < 2; ++h)
#pragma unroll
            for (int i = 0; i < 2; ++i) vo[h][i] = (unsigned)(((h * HALF + R[i]) * K + C[i]) * 2);
    }
};

template <class Epi, class Sched, bool ALIGN_EPI>
__device__ __forceinline__ void gemm_phase(LAS unsigned char* lds, const int K, const Sched& S, const Epi& E) {
    const int tid = opaque_tid(), wid = __builtin_amdgcn_readfirstlane(tid >> 6), lane = tid & 63, wr = wid >> 2, wc = wid & 3, fr = lane & 15, fq = lane >> 4;
    const int nt = K / BK;
    int Rr[2], Cc[2]; unsigned voffB[2];
#pragma unroll
    for (int i = 0; i < 2; ++i) { int R, C; stage_rc(tid * 16 + i * 8192, R, C); const int Rb = Epi::PERM ? ((R & ~31) + perm32(R & 31)) : R;
        Rr[i] = R; Cc[i] = C; voffB[i] = (unsigned)(Rb * K + C) * 2u; }
    const size_t kstep = (size_t)(BK * 2);
    const size_t hstepB = (size_t)HALF * K * 2;
    const unsigned ldsw = (unsigned)wid * 1024u;
    const int aoff = lds_byte(wr * 64 + fr, fq * 8), boff = lds_byte(wc * 32 + fr, fq * 8);
#define PG8_SA(b, h) (((b) * 2 + (h)) * HTB)
#define PG8_SB(b, h) ((4 + (b) * 2 + (h)) * HTB)
#define PG8_STAGE(bufoff, gbase, voff) do { _Pragma("unroll") for (int _i = 0; _i < 2; ++_i) \
        __builtin_amdgcn_global_load_lds((const unsigned*)((const char*)(gbase) + (voff)[_i]), (LAS unsigned*)(lds + (bufoff) + ldsw + _i * 8192), 16, 0, 0); } while (0)
#define PG8_LDA(dst, b, h) do { _Pragma("unroll") for (int m = 0; m < 4; ++m) _Pragma("unroll") for (int k = 0; k < 2; ++k) dst[m][k] = *(const LAS bf16x8*)(lds + PG8_SA(b, h) + aoff + m * 2048 + k * 1024); } while (0)
#define PG8_LDB(dst, b, h) do { _Pragma("unroll") for (int n = 0; n < 2; ++n) _Pragma("unroll") for (int k = 0; k < 2; ++k) dst[n][k] = *(const LAS bf16x8*)(lds + PG8_SB(b, h) + boff + n * 2048 + k * 1024); } while (0)
#define PG8_MMA(ai, bj, At, Bt) do { __builtin_amdgcn_s_setprio(1); _Pragma("unroll") for (int m = 0; m < 4; ++m) _Pragma("unroll") for (int n = 0; n < 2; ++n) _Pragma("unroll") for (int k = 0; k < 2; ++k) \
        acc[ai][bj][m][n] = __builtin_amdgcn_mfma_f32_16x16x32_bf16(Bt[n][k], At[m][k], acc[ai][bj][m][n], 0, 0, 0); __builtin_amdgcn_s_setprio(0); } while (0)
#define PG8_WAIT_V(n) asm volatile("s_waitcnt vmcnt(" #n ")" ::: "memory")
#define PG8_WAIT_L(n) asm volatile("s_waitcnt lgkmcnt(" #n ")" ::: "memory")
#define PG8_BAR __builtin_amdgcn_s_barrier()
#define PG8_SCHED __builtin_amdgcn_sched_barrier(0)
    Unit cur, nxt; int ui = 0;
    if (!S.next(0, cur)) return;
    f32x4 acc[2][2][4][2];
#pragma unroll
    for (int a = 0; a < 2; ++a)
#pragma unroll
        for (int b = 0; b < 2; ++b)
#pragma unroll
            for (int m = 0; m < 4; ++m)
#pragma unroll
                for (int n = 0; n < 2; ++n) acc[a][b][m][n] = (f32x4){0.f, 0.f, 0.f, 0.f};
    bf16x8 At[4][2], B0[2][2], B1[2][2];
    unsigned vo[2][2];
    S.aoff(cur, Rr, Cc, vo);
    {
        const char* cA = cur.A; const char* cB = cur.B;
        PG8_STAGE(PG8_SB(0, 0), cB, voffB); PG8_STAGE(PG8_SB(0, 1), cB + hstepB, voffB); PG8_STAGE(PG8_SA(0, 0), cA, vo[0]); PG8_STAGE(PG8_SA(0, 1), cA, vo[1]);
        if (wr == 1) PG8_BAR;
        PG8_WAIT_V(2); PG8_BAR;
        PG8_STAGE(PG8_SB(1, 0), cB + kstep, voffB); PG8_STAGE(PG8_SA(1, 0), cA + kstep, vo[0]); PG8_STAGE(PG8_SB(1, 1), cB + hstepB + kstep, voffB);
        PG8_WAIT_V(6); PG8_BAR;
    }
    for (;;) {
        const bool has_next = S.next(ui + 1, nxt);
        const char* cA = cur.A; const char* cB = cur.B;
        const char* nA = has_next ? nxt.A : cA; const char* nB = has_next ? nxt.B : cB;
        const bool full = Sched::ALWAYS_FULL ? true : (cur.nvalid > 128);
        for (int t = 0; t < nt; t += 2) {
            const bool last = (t == nt - 2);
            const char* a1 = cA + (size_t)(t + 1) * kstep;
            const char* a2 = last ? nA : cA + (size_t)(t + 2) * kstep; const char* b2 = last ? nB : cB + (size_t)(t + 2) * kstep;
            const char* a3 = a2 + kstep; const char* b3 = b2 + kstep;
            PG8_LDB(B0, 0, 0); PG8_LDB(B1, 0, 1); PG8_SCHED; PG8_LDA(At, 0, 0); PG8_STAGE(PG8_SA(1, 1), a1, vo[1]);
            if (last && has_next) S.aoff(nxt, Rr, Cc, vo);
            PG8_WAIT_V(8); PG8_WAIT_L(0); PG8_BAR; PG8_MMA(0, 0, At, B0); PG8_MMA(0, 1, At, B1); PG8_BAR; PG8_SCHED;
            PG8_LDA(At, 0, 1); PG8_STAGE(PG8_SB(0, 0), b2, voffB); PG8_STAGE(PG8_SB(0, 1), b2 + hstepB, voffB); PG8_STAGE(PG8_SA(0, 0), a2, vo[0]);
            PG8_WAIT_V(8); PG8_WAIT_L(0); PG8_BAR; if (full) { PG8_MMA(1, 0, At, B0); PG8_MMA(1, 1, At, B1); } PG8_BAR; PG8_SCHED;
            PG8_LDB(B0, 1, 0); PG8_LDB(B1, 1, 1); PG8_SCHED; PG8_LDA(At, 1, 0); PG8_STAGE(PG8_SA(0, 1), a2, vo[1]);
            PG8_WAIT_V(8); PG8_WAIT_L(0); PG8_BAR; PG8_MMA(0, 0, At, B0); PG8_MMA(0, 1, At, B1); PG8_BAR; PG8_SCHED;
            PG8_LDA(At, 1, 1); PG8_STAGE(PG8_SB(1, 0), b3, voffB); PG8_STAGE(PG8_SB(1, 1), b3 + hstepB, voffB); PG8_STAGE(PG8_SA(1, 0), a3, vo[0]);
            PG8_WAIT_V(8); PG8_WAIT_L(0); PG8_BAR; if (full) { PG8_MMA(1, 0, At, B0); PG8_MMA(1, 1, At, B1); } PG8_BAR; PG8_SCHED;
        }
        if constexpr (ALIGN_EPI) { if (wr == 0) PG8_BAR; }
        E(acc, cur, wr, wc, fr, fq);
        if (!has_next) break;
#pragma unroll
        for (int a = 0; a < 2; ++a)
#pragma unroll
            for (int b = 0; b < 2; ++b)
#pragma unroll
                for (int m = 0; m < 4; ++m)
#pragma unroll
                    for (int n = 0; n < 2; ++n) acc[a][b][m][n] = (f32x4){0.f, 0.f, 0.f, 0.f};
        cur = nxt; ++ui;
        if constexpr (ALIGN_EPI) { if (wr == 1) PG8_BAR; }
    }
    PG8_WAIT_V(0);
    if constexpr (!ALIGN_EPI) { if (wr == 0) PG8_BAR; }
    PG8_BAR;
#undef PG8_SA
#undef PG8_SB
#undef PG8_STAGE
#undef PG8_LDA
#undef PG8_LDB
#undef PG8_MMA
#undef PG8_WAIT_V
#undef PG8_WAIT_L
#undef PG8_BAR
#undef PG8_SCHED
}

template <bool ODD> struct EpiZ {
    static constexpr bool PERM = true;
    bf16_t* Z; float* vstat; const float* rstd;
    __device__ __forceinline__ void operator()(const f32x4 (&acc)[2][2][4][2], const Unit& u, int wr, int wc, int fr, int fq) const {
        const int row0 = u.rowbase + wr * 64 + fr; const int col0 = u.pn * BM + wc * 32 + 8 * fq;
        float rsv[2][4];
#pragma unroll
        for (int ai = 0; ai < 2; ++ai)
#pragma unroll
            for (int m = 0; m < 4; ++m) rsv[ai][m] = rstd[row0 + ai * HALF + m * 16];
#pragma unroll
        for (int ai = 0; ai < 2; ++ai)
#pragma unroll
            for (int m = 0; m < 4; ++m) {
                const int row = row0 + ai * HALF + m * 16;
                bf16_t* rowp = Z + (size_t)row * ZP + col0;
                float s = 0.f, q = 0.f;
#pragma unroll
                for (int bj = 0; bj < 2; ++bj) {
                    f32x4 v0 = acc[ai][bj][m][0] * rsv[ai][m], v1 = acc[ai][bj][m][1] * rsv[ai][m];
                    if (ODD) {
#pragma unroll
                        for (int j = 0; j < 4; ++j) { v0[j] = gelu_tanh(v0[j]); v1[j] = gelu_tanh(v1[j]); s += v0[j] + v1[j]; q += v0[j] * v0[j] + v1[j] * v1[j]; }
                    }
                    u32x4 w; w.x = cvt_pk_bf16(v0[0], v0[1]); w.y = cvt_pk_bf16(v0[2], v0[3]); w.z = cvt_pk_bf16(v1[0], v1[1]); w.w = cvt_pk_bf16(v1[2], v1[3]);
                    *(u32x4*)(rowp + bj * HALF) = w;
                }
                if (ODD) {
                    s += __shfl_xor(s, 16); s += __shfl_xor(s, 32); q += __shfl_xor(q, 16); q += __shfl_xor(q, 32);
                    if (u.pn >= 4 && fq == 0) *(f32x2*)(vstat + ((size_t)row * 16 + (u.pn - 4) * 4 + wc) * 2) = (f32x2){s, q};
                }
            }
    }
};
struct EpiResid {
    static constexpr bool PERM = true;
    const bf16_t* __restrict__ Xin; bf16_t* __restrict__ Xout;
    __device__ __forceinline__ void operator()(const f32x4 (&acc)[2][2][4][2], const Unit& u, int wr, int wc, int fr, int fq) const {
        const int row0 = u.rowbase + wr * 64 + fr, col0 = u.pn * BM + wc * 32 + 8 * fq;
#pragma unroll
        for (int ai = 0; ai < 2; ++ai) {
            u32x4 t[4][2];
#pragma unroll
            for (int m = 0; m < 4; ++m) { const bf16_t* rowp = Xin + (size_t)(row0 + ai * HALF + m * 16) * DM + col0;
#pragma unroll
                for (int bj = 0; bj < 2; ++bj) t[m][bj] = *(const u32x4*)(rowp + bj * HALF); }
#pragma unroll
            for (int m = 0; m < 4; ++m) { bf16_t* rowp = Xout + (size_t)(row0 + ai * HALF + m * 16) * DM + col0;
#pragma unroll
                for (int bj = 0; bj < 2; ++bj) { const f32x4 v0 = acc[ai][bj][m][0], v1 = acc[ai][bj][m][1]; const u32x4 x = t[m][bj]; u32x4 w;
                    w.x = cvt_pk_bf16(bf_lo(x.x) + v0[0], bf_hi(x.x) + v0[1]); w.y = cvt_pk_bf16(bf_lo(x.y) + v0[2], bf_hi(x.y) + v0[3]);
                    w.z = cvt_pk_bf16(bf_lo(x.z) + v1[0], bf_hi(x.z) + v1[1]); w.w = cvt_pk_bf16(bf_lo(x.w) + v1[2], bf_hi(x.w) + v1[3]);
                    *(u32x4*)(rowp + bj * HALF) = w; } }
        }
    }
};
}

struct Args { const float* in[20]; float* out; unsigned char* ws; int ph_lo, ph_hi; };
static_assert(sizeof(Args) == 184, "Args layout");
struct Frame {
    LAS unsigned char* lds;
};
#define F_TID (opaque_tid())
#define F_LANE (opaque_tid() & 63)
#define F_WAVE (__builtin_amdgcn_readfirstlane(opaque_tid() >> 6))
#define F_G ((int)gridDim.x)
#define F_BID ((int)blockIdx.x)
#define CAS __attribute__((address_space(4)))
__device__ __forceinline__ const CAS char* karg_base() { const CAS char* p = (const CAS char*)__builtin_amdgcn_kernarg_segment_ptr(); asm volatile("" : "+s"(p)); return p; }
#define KIN(k) ((const float*)(*(const GAS float* const CAS*)(karg_base() + 8 * (k))))
#define F_WS ((unsigned char*)(*(GAS unsigned char* const CAS*)(karg_base() + 168)))
#define F_X ((float*)(*(GAS float* const CAS*)(karg_base() + 160)))
#define F_CTL ((unsigned*)(F_WS + WS_CTL))

namespace pg4 {
constexpr int BPL = 4352;
struct Unit4 { int rowbase; int pn; int nvalid; int slot; };
__device__ __forceinline__ int off32(int r, int c) { const int ob = (r & 15) * 64 + c * 2; return (r >> 4) * 1024 + (ob ^ (((ob >> 9) & 1) << 5)); }
__device__ __forceinline__ void stage_rc32(int b, int& R, int& C) { const int st = b >> 10, sb = b & 1023, swz = sb ^ (((sb >> 9) & 1) << 5); R = st * 16 + (swz >> 6); C = (swz & 63) >> 1; }

__device__ __forceinline__ void epi_gu4(bf16_t* H, const LAS float* rstd, const f32x4 (&acc)[8][4], const Unit4& u, int wr, int wc, int fr, int fq) {
    asm volatile("" : "+v"(fr), "+v"(fq));
    const int col0 = u.pn * 128 + wc * 32 + 8 * fq;
    const __amdgpu_buffer_rsrc_t hrs = __builtin_amdgcn_make_buffer_rsrc(H, 0, NR_ALLOC * DE * 2, 0x00020000);
#pragma unroll
    for (int m = 0; m < 8; ++m) {
        const int lr = wr * 128 + m * 16 + fr;
        if (lr < u.nvalid) {
            const float rr = rstd[u.slot * 256 + lr];
            const f32x4 g0 = acc[m][0] * rr, g1 = acc[m][1] * rr, u0 = acc[m][2] * rr, u1 = acc[m][3] * rr; u32x4 w;
            w.x = cvt_pk_bf16(silu_f(g0[0]) * u0[0], silu_f(g0[1]) * u0[1]); w.y = cvt_pk_bf16(silu_f(g0[2]) * u0[2], silu_f(g0[3]) * u0[3]);
            w.z = cvt_pk_bf16(silu_f(g1[0]) * u1[0], silu_f(g1[1]) * u1[1]); w.w = cvt_pk_bf16(silu_f(g1[2]) * u1[2], silu_f(g1[3]) * u1[3]);
            __builtin_amdgcn_raw_buffer_store_b128(w, hrs, (unsigned)(((u.rowbase + lr) * DE + col0) * 2), 0,   16);
        }
    }
}
__device__ __forceinline__ void epi_down4(bf16_t* Y, const LAS float* gates, const f32x4 (&acc)[8][4], const Unit4& u, int wr, int wc, int fr, int fq) {
    asm volatile("" : "+v"(fr), "+v"(fq));
    const int col0 = u.pn * 256 + wc * 64 + 16 * fq;
#pragma unroll
    for (int m = 0; m < 8; ++m) {
        const int lr = wr * 128 + m * 16 + fr;
        if (lr < u.nvalid) {
            const float g = gates[u.slot * 256 + lr];
#pragma unroll
            for (int n2 = 0; n2 < 2; ++n2) { const f32x4 v0 = acc[m][2 * n2] * g, v1 = acc[m][2 * n2 + 1] * g; u32x4 w;
                w.x = cvt_pk_bf16(v0[0], v0[1]); w.y = cvt_pk_bf16(v0[2], v0[3]); w.z = cvt_pk_bf16(v1[0], v1[1]); w.w = cvt_pk_bf16(v1[2], v1[3]);
                *(u32x4*)(Y + (size_t)(u.rowbase + lr) * DM + col0 + 8 * n2) = w; }
        }
    }
}
template <int MODE  , int NT  , int LDB>
__device__ __forceinline__ void gemm4_phase(LAS unsigned char* lds, const LAS int* tab, const LAS unsigned short* toks, const LAS float* gates  , const char* Abase, const float* W0, const float* W1, const float* Gk, bf16_t* Out, const int layer, const int nunits) {
    const int tid = opaque_tid(), wid = __builtin_amdgcn_readfirstlane(tid >> 6), lane = tid & 63, wr = wid >> 2, wc = wid & 3, fr = lane & 15, fq = lane >> 4;
    if (nunits <= 0) return;
    constexpr int ABLK = 32768, BOFF = 3 * ABLK, BSTG = 4 * BPL;
    const unsigned ldsw = (unsigned)wid * 1024u;
    const int aoff = wr * 16384 + pg8::lds_byte(fr, fq * 8);
    const int boff = BOFF + fq * BPL + ((fr & 3) * 68 + ((wc * 64 + fr) >> 2)) * 16;
    const int kg = wid, ng = lane;
    const unsigned bw0 = (unsigned)(BOFF + (kg >> 1) * BPL + ng * 16 + 8 * (kg & 1));
    const int bsel = MODE == 0 ? ((ng >> 3) & 1) : 0;
    const int bcolv = MODE == 0 ? (32 * (ng >> 4) + 8 * (ng & 3) + 4 * ((ng >> 2) & 1)) : (64 * (ng >> 4) + 16 * (ng & 3) + 4 * ((ng >> 2) & 3));
    const unsigned bthr = (unsigned)((4 * kg * LDB + bcolv) * 4);
    const int TT = nunits * NT;
    Unit4 uc; int sa = 0, sb = 0, sc2 = 0, ka = 0, kb = 0, kc = 0;
#define G4_NEXTC(i) do { uc.rowbase = __builtin_amdgcn_readfirstlane(tab[(i) * 8 + 3]); uc.nvalid = __builtin_amdgcn_readfirstlane(tab[(i) * 8 + 4]); uc.pn = __builtin_amdgcn_readfirstlane(tab[(i) * 8 + 2]); uc.slot = (i); } while (0)
#define G4_NEXTA(i) do { if (MODE == 0) curA = Abase; else curA = Abase + (size_t)__builtin_amdgcn_readfirstlane(tab[(i) * 8 + 3]) * DE * 2; \
        _Pragma("unroll") for (int _h = 0; _h < 2; ++_h) _Pragma("unroll") for (int _i = 0; _i < 2; ++_i) { int _R, _C; pg8::stage_rc(tid * 16 + _i * 8192, _R, _C); \
            vo[_h][_i] = MODE == 0 ? (unsigned)(((int)toks[(i) * 256 + _h * 128 + _R] * DM + _C) * 2) : (unsigned)(((_h * 128 + _R) * DE + _C) * 2); } } while (0)
#define G4_NEXTB(i) do { const int _e = __builtin_amdgcn_readfirstlane(tab[(i) * 8 + 0]), _ct = __builtin_amdgcn_readfirstlane(tab[(i) * 8 + 2]); \
        if (MODE == 0) { const size_t _wo = (size_t)(layer * NE + _e) * DM * DE + (size_t)_ct * 128; curB0 = W0 + _wo; curB1 = W1 + _wo; } \
        else { curB0 = W0 + (size_t)(layer * NE + _e) * DE * DM + (size_t)_ct * 256; curB1 = curB0; } } while (0)
    const char* curA; const float* curB0; const float* curB1; unsigned vo[2][2];
    G4_NEXTC(0); G4_NEXTA(0); G4_NEXTB(0);
    f32x4 acc[8][4];
#pragma unroll
    for (int m = 0; m < 8; ++m)
#pragma unroll
        for (int n = 0; n < 4; ++n) acc[m][n] = (f32x4){0.f, 0.f, 0.f, 0.f};
    f32x4 Br[3][4];
#define G4_ISSUE_A(blk) do { const char* _ap = curA + (size_t)ka * 128; \
        _Pragma("unroll") for (int _h = 0; _h < 2; ++_h) _Pragma("unroll") for (int _i = 0; _i < 2; ++_i) \
            __builtin_amdgcn_global_load_lds((const unsigned*)(_ap + vo[_h][_i]), (LAS unsigned*)(lds + (blk) * ABLK + _h * 16384 + ldsw + _i * 8192), 16, 0, 0); \
        if (++ka == NT / 2) { ka = 0; if (sa + 1 < nunits) { ++sa; G4_NEXTA(sa); } } } while (0)
#define G4_ISSUE_B(rs) do { const char* _bp = (const char*)(bsel ? curB1 : curB0) + (size_t)kb * (32 * LDB * 4) + bthr; \
        _Pragma("unroll") for (int _j = 0; _j < 4; ++_j) { const char* _p = _bp + (size_t)_j * (LDB * 4); \
            asm volatile("global_load_dwordx4 %0, %1, off ; G4_BLOAD" : "=&v"(Br[rs][_j]) : "v"(_p) : "memory"); } \
        if (++kb == NT) { kb = 0; if (sb + 1 < nunits) { ++sb; G4_NEXTB(sb); } } } while (0)
    f32x4 gq[2] = {(f32x4){1.f, 1.f, 1.f, 1.f}, (f32x4){1.f, 1.f, 1.f, 1.f}};
#define G4_LOAD_G(q, kstep) do { if (MODE == 0) { const float* _gp = Gk + (((kstep) & (NT - 1)) * 32 + 4 * kg); asm volatile("s_load_dwordx4 %0, %1, 0x0" : "=s"(gq[q]) : "s"(_gp) : "memory"); } } while (0)
#define G4_FENCE_G() do { if (MODE == 0) asm volatile("" : "+s"(gq[0]), "+s"(gq[1])); } while (0)
#define G4_WRITE_B(rs, bst, q) do { _Pragma("unroll") for (int _i = 0; _i < 4; ++_i) { u32x2 _w; \
        if (MODE == 0) { _w.x = cvt_pk_bf16(Br[rs][0][_i] * gq[q][0], Br[rs][1][_i] * gq[q][1]); _w.y = cvt_pk_bf16(Br[rs][2][_i] * gq[q][2], Br[rs][3][_i] * gq[q][3]); } \
        else { _w.x = cvt_pk_bf16(Br[rs][0][_i], Br[rs][1][_i]); _w.y = cvt_pk_bf16(Br[rs][2][_i], Br[rs][3][_i]); } \
        *(LAS u32x2*)(lds + (bst) * BSTG + bw0 + 1088 * _i) = _w; } } while (0)
#define G4_WAIT_V(n) asm volatile("s_waitcnt vmcnt(" #n ")" ::: "memory")
#define G4_WAIT_L(n) asm volatile("s_waitcnt lgkmcnt(" #n ")" ::: "memory")
    G4_LOAD_G(0, 0); G4_LOAD_G(1, 1);
    G4_ISSUE_B(0); G4_ISSUE_A(0); G4_ISSUE_A(1); G4_ISSUE_B(1); G4_ISSUE_B(2); G4_WAIT_V(16); G4_WAIT_L(0); G4_FENCE_G(); G4_WRITE_B(0, 0, 0);
    G4_WAIT_V(12);
    int pendT = 0, pendB = 0; bool act0 = (wr < 1) || uc.nvalid > 128;
    int T = 0;
    bf16x8 Bf[4], Af[4];
#pragma unroll
    for (int i = 0; i < 4; ++i) { Bf[i] = (bf16x8){0, 0, 0, 0, 0, 0, 0, 0}; Af[i] = (bf16x8){0, 0, 0, 0, 0, 0, 0, 0}; }
#define G4_WAIT_TOP() do { if (pendT) { if (MODE == 0) G4_WAIT_V(28); else G4_WAIT_V(36); --pendT; } else G4_WAIT_V(20); } while (0)
#define G4_WAIT_B() do { if (pendB) { if (MODE == 0) G4_WAIT_V(16); else G4_WAIT_V(24); --pendB; } else G4_WAIT_V(8); } while (0)
#define G4_STEP(ab, p, rs) do { \
        if ((p) == 0) { G4_WAIT_TOP(); } \
        G4_WAIT_L(0); G4_FENCE_G(); __builtin_amdgcn_s_barrier(); \
        if ((p) == 0) { G4_ISSUE_A(((ab) + 2) % 3); } \
        if (act0) { \
            _Pragma("unroll") for (int n = 0; n < 4; ++n) Bf[n] = *(const LAS bf16x8*)(lds + (p) * BSTG + boff + n * 64); \
            _Pragma("unroll") for (int m = 0; m < 4; ++m) Af[m] = *(const LAS bf16x8*)(lds + (ab) * ABLK + aoff + m * 2048 + (p) * 1024); } \
        G4_WAIT_B(); asm volatile("; G4_BWAIT" ::: "memory"); \
        G4_WRITE_B(((rs) + 1) % 3, 1 - (p), 1 - (p)); G4_LOAD_G(p, T + 2); \
        G4_ISSUE_B(rs); \
        if (act0) { __builtin_amdgcn_s_setprio(1); \
            _Pragma("unroll") for (int m = 0; m < 4; ++m) _Pragma("unroll") for (int n = 0; n < 4; ++n) acc[m][n] = __builtin_amdgcn_mfma_f32_16x16x32_bf16(Bf[n], Af[m], acc[m][n], 0, 0, 0); \
            __builtin_amdgcn_s_setprio(0); \
            _Pragma("unroll") for (int m = 0; m < 4; ++m) Af[m] = *(const LAS bf16x8*)(lds + (ab) * ABLK + aoff + (m + 4) * 2048 + (p) * 1024); \
            __builtin_amdgcn_s_setprio(1); \
            _Pragma("unroll") for (int m = 0; m < 4; ++m) _Pragma("unroll") for (int n = 0; n < 4; ++n) acc[m + 4][n] = __builtin_amdgcn_mfma_f32_16x16x32_bf16(Bf[n], Af[m], acc[m + 4][n], 0, 0, 0); \
            __builtin_amdgcn_s_setprio(0); } \
        if (++kc == NT) { kc = 0; \
            if (MODE == 0) epi_gu4(Out, gates, acc, uc, wr, wc, fr, fq); else epi_down4(Out, gates, acc, uc, wr, wc, fr, fq); \
            if (wr < 1 || uc.nvalid > 128) { pendT = 2; pendB = 2; } else { pendT = 0; pendB = 0; } \
            _Pragma("unroll") for (int m = 0; m < 8; ++m) _Pragma("unroll") for (int n = 0; n < 4; ++n) acc[m][n] = (f32x4){0.f, 0.f, 0.f, 0.f}; \
            if (sc2 + 1 < nunits) { ++sc2; G4_NEXTC(sc2); act0 = (wr < 1) || uc.nvalid > 128; } } \
        ++T; } while (0)
    while (T + 6 <= TT) { G4_STEP(0, 0, 0); G4_STEP(0, 1, 1); G4_STEP(1, 0, 2); G4_STEP(1, 1, 0); G4_STEP(2, 0, 1); G4_STEP(2, 1, 2); }
    if (T + 2 <= TT) { G4_STEP(0, 0, 0); G4_STEP(0, 1, 1);
        if (T + 2 <= TT) { G4_STEP(1, 0, 2); G4_STEP(1, 1, 0); } }
    G4_WAIT_V(0); G4_WAIT_L(0); __builtin_amdgcn_s_barrier();
#pragma unroll
    for (int rs = 0; rs < 3; ++rs)
#pragma unroll
        for (int j = 0; j < 4; ++j) asm volatile("" :: "v"(Br[rs][j]));
#undef G4_NEXTA
#undef G4_NEXTB
#undef G4_NEXTC
#undef G4_ISSUE_A
#undef G4_ISSUE_B
#undef G4_WRITE_B
#undef G4_LOAD_G
#undef G4_FENCE_G
#undef G4_WAIT_V
#undef G4_WAIT_L
#undef G4_WAIT_TOP
#undef G4_WAIT_B
#undef G4_STEP
}
}

struct MoeTabs { LAS int* cnt; LAS int* seg; LAS int* fst; LAS int* hst; LAS int* tab; LAS int* nmy; LAS unsigned short* toks; LAS float* gates; LAS float* rstd; };
__device__ __forceinline__ MoeTabs moe_tabs(Frame& F) {
    MoeTabs T; LAS unsigned char* m = F.lds + MISC_OFF;
    T.cnt = (LAS int*)(m + MO_CNT); T.seg = (LAS int*)(m + MO_SEG); T.fst = (LAS int*)(m + MO_FST); T.hst = (LAS int*)(m + MO_HST); T.tab = (LAS int*)(m + MO_TAB); T.nmy = (LAS int*)(m + MO_NMY);
    T.toks = (LAS unsigned short*)(m + MO_TOKS); T.gates = (LAS float*)(m + MO_GATES); T.rstd = (LAS float*)(m + MO_RSTD); return T;
}
__device__ __forceinline__ void moe_build_seg(Frame& F, const Args& AR, const MoeTabs& T, int layer) {
    __syncthreads();
    if (F_TID < NE) T.cnt[F_TID] = (int)__hip_atomic_load(F_CTL + CW_CNT + (layer * NE + F_TID) * 64, __ATOMIC_RELAXED, __HIP_MEMORY_SCOPE_AGENT);
    __syncthreads();
    if (F_TID < NE) {
        const int e = F_TID, c = T.cnt[e], nb = (c + 127) >> 7;
        int s = nb * 128, fs = (nb >> 1) * 4, hs = (nb & 1) * 4;
        const int s0 = s, f0 = fs, h0 = hs;
#pragma unroll
        for (int o = 1; o < 64; o <<= 1) { const int a = __shfl_up(s, o), b = __shfl_up(fs, o), d = __shfl_up(hs, o); if (e >= o) { s += a; fs += b; hs += d; } }
        T.seg[e] = s - s0; T.fst[e] = fs - f0; T.hst[e] = hs - h0;
        if (e == NE - 1) { T.seg[NE] = s; T.fst[NE] = fs; T.hst[NE] = hs; }
    }
    __syncthreads();
}
__device__ __forceinline__ int moe_build_units(Frame& F, const Args& AR, const MoeTabs& T, int layer, int base, bool build, const int nfull, const int total, const bool deal2, int& nfw, const int sl0 = 0  ) {
    const int vcu = (F_G % 8 == 0) ? (F_BID % 8) * (F_G / 8) + F_BID / 8 : F_BID;
    int n = (total - base - vcu + F_G - 1) / F_G; n = n < 0 ? 0 : (n > MAXU ? MAXU : n);
    const int rv = F_G - 1 - vcu;
    nfw = (nfull - vcu + F_G - 1) / F_G; nfw = nfw < 0 ? 0 : (nfw > MAXU ? MAXU : nfw);
    if (deal2) { int nhw = (total - nfull - rv + F_G - 1) / F_G; nhw = nhw < 0 ? 0 : nhw; n = nfw + nhw; n = n > MAXU ? MAXU : n; }
    if (!build) return n;
    if (F_TID < 64) {
        const int e = F_TID; const int fa = T.fst[e], fb = T.fst[e + 1], ha = T.hst[e], hb = T.hst[e + 1];
#pragma unroll
        for (int i = 0; i < MAXU; ++i) {
            if (i >= sl0 && i < n) {
                const int L = deal2 ? (i < nfw ? i * F_G + vcu : nfull + (i - nfw) * F_G + rv) : base + i * F_G + vcu;
                const bool isf = L < nfull; const int Lr = isf ? L : L - nfull;
                const bool mine = isf ? (fa <= Lr && Lr < fb) : (ha <= Lr && Lr < hb);
                const unsigned long long mk = __ballot(mine);
                const int ee = (int)__builtin_ctzll(mk);
                if (e == ee) { const int r = Lr - (isf ? fa : ha), c = T.cnt[e]; const int nb = (c + 127) >> 7;
                    const int rb = isf ? (r >> 2) : (nb >> 1), ct = r & 3;
                    LAS int* t = T.tab + i * 8; t[0] = e; t[1] = rb; t[2] = ct; t[3] = T.seg[e] + rb * 256; t[4] = isf ? 256 : 128; t[5] = c - rb * 256; }
            }
        }
    }
    __syncthreads();
    const i32x4* list = (const i32x4*)(F_WS + WS_LIST);
    {
        const int tid = F_TID, row = tid & 255, sh = tid >> 8;
        i32x4 v[MAXU / 2];
#pragma unroll
        for (int p = 0; p < MAXU / 2; ++p) { const int sl = 2 * p + sh; v[p] = (i32x4){ZERO_ROW, 0, 0, 0};
            if (sl >= sl0 && sl < n) { const int e = T.tab[sl * 8 + 0], rb = T.tab[sl * 8 + 1], cl = T.tab[sl * 8 + 5];
                if (row < cl) v[p] = list[(size_t)e * NT + rb * 256 + row]; } }
#pragma unroll
        for (int p = 0; p < MAXU / 2; ++p) { const int sl = 2 * p + sh;
            if (sl >= sl0 && sl < n) { const int vx = v[p].x, vy = v[p].y, vz = v[p].z; T.toks[sl * 256 + row] = (unsigned short)vx; T.gates[sl * 256 + row] = __int_as_float(vy); T.rstd[sl * 256 + row] = __int_as_float(vz); } }
    }
    __syncthreads();
    return n;
}
constexpr int BLK_CTRS = 384;
__device__ __forceinline__ bool moe_fusable(int nfull, int total, int G) { return total <= MAXU * G && ((nfull + G - 1) / G + (total - nfull + G - 1) / G) <= MAXU; }
__device__ __forceinline__ void moe_publish(Frame& F, const Args& AR, const MoeTabs& T, int layer, int n) {
    if (F_TID < 64) {
        if (F_TID < n) { unsigned* c = F_CTL + CW_BLK + ((size_t)layer * BLK_CTRS + (T.tab[F_TID * 8 + 3] >> 7)) * 16; (void)xb_add(c, 1u); }
    }
}
__device__ __forceinline__ void moe_wait(Frame& F, const Args& AR, const MoeTabs& T, int layer, int s0, int s1) {
    if (F_TID < 64) {
        const int i = s0 + F_TID;
        if (i < s1) { unsigned* c = F_CTL + CW_BLK + ((size_t)layer * BLK_CTRS + (T.tab[i * 8 + 3] >> 7)) * 16; unsigned* bar = F_CTL + CW_BAR;
            XB_SPIN(xb_ld(c) < 4u, bar); }
        if (F_TID == 0) __builtin_amdgcn_fence(__ATOMIC_ACQUIRE, "agent");
    }
    asm volatile("s_waitcnt vmcnt(0)" ::: "memory");
    __syncthreads();
}
__device__ __forceinline__ unsigned f2bf(float f) { unsigned u = __builtin_bit_cast(unsigned, f); return (u + 0x7fffu + ((u >> 16) & 1u)) >> 16; }
__device__ __forceinline__ unsigned pk2(float lo, float hi) { return f2bf(lo) | (f2bf(hi) << 16); }
__device__ __forceinline__ void p0_transpose_item(const float* W, int N, bf16_t* WT, int Kd, int k0, int n0, int drow0, LAS float* scr, int lane, const float* gk) {
#pragma unroll 8
    for (int i = 0; i < 32; ++i) { const int kk = 2 * i + (lane >> 5); scr[kk * 33 + (lane & 31)] = W[(size_t)(k0 + kk) * N + n0 + (lane & 31)]; }
    LDS_WAIT(); asm volatile("" ::: "memory");
    const int c = lane & 7;
    f32x4 g0 = (f32x4){1.f, 1.f, 1.f, 1.f}, g1 = g0;
    if (gk) { g0 = *(const f32x4*)(gk + k0 + 8 * c); g1 = *(const f32x4*)(gk + k0 + 8 * c + 4); }
#pragma unroll
    for (int j = 0; j < 4; ++j) { const int n = (lane >> 3) + 8 * j; const LAS float* s = scr + (8 * c) * 33 + n;
        u32x4 o; o.x = pk2(s[0 * 33] * g0.x, s[1 * 33] * g0.y); o.y = pk2(s[2 * 33] * g0.z, s[3 * 33] * g0.w); o.z = pk2(s[4 * 33] * g1.x, s[5 * 33] * g1.y); o.w = pk2(s[6 * 33] * g1.z, s[7 * 33] * g1.w);
        *(u32x4*)(WT + (size_t)(drow0 + n) * Kd + k0 + 8 * c) = o; }
    LDS_WAIT(); asm volatile("" ::: "memory");
}
__device__ __forceinline__ void row_rstd(const f32x4 (&v)[4], int lane, float* out) {
    float s = 0.f;
#pragma unroll
    for (int j = 0; j < 4; ++j) s += (v[j].x * v[j].x + v[j].y * v[j].y) + (v[j].z * v[j].z + v[j].w * v[j].w);
    const float rstd = 1.0f / sqrtf(wave_sum(s) * (1.f / DM) + EPS);
    if (lane == 0) *out = rstd;
}
__device__ __forceinline__ void norm_row(const f32x4 (&v)[4], const float* g, int lane, bf16_t* ob, float* of, float oscale = 1.0f) {
    float s = 0.f;
#pragma unroll
    for (int j = 0; j < 4; ++j) s += (v[j].x * v[j].x + v[j].y * v[j].y) + (v[j].z * v[j].z + v[j].w * v[j].w);
    const float rstd = oscale / sqrtf(wave_sum(s) * (1.f / DM) + EPS);
#pragma unroll
    for (int j = 0; j < 4; ++j) {
        const f32x4 gg = *((const f32x4*)g + lane + 64 * j);
        const f32x4 y = v[j] * rstd * gg;
        if (ob) { u32x2 w; w.x = cvt_pk_bf16(y.x, y.y); w.y = cvt_pk_bf16(y.z, y.w); *((u32x2*)ob + lane + 64 * j) = w; }
        if (of) *((f32x4*)of + lane + 64 * j) = y;
    }
}
__device__ __forceinline__ void p0_prologue(Frame& F, const Args& AR) {
    LAS float* scr = (LAS float*)(F.lds + F_WAVE * 16384);
    const int gw = F_BID * NWAVES + F_WAVE, NGW = F_G * NWAVES;
    bf16_t* WIN = (bf16_t*)(F_WS + WS_WIN); bf16_t* WOUT = (bf16_t*)(F_WS + WS_WOUT);
    constexpr int I_IN = 16 * 64, I_OUT = 16 * 32, I_MIX = NL * (I_IN + I_OUT);
    for (int it = gw; it < I_MIX; it += NGW) {
        if (it < NL * I_IN) { const int l = it / I_IN, r = it % I_IN, kb = r / 64, nb = r % 64;
            const float* W = ((l & 1) ? KIN(8) : KIN(4)) + (size_t)(l >> 1) * DM * 2048;
            p0_transpose_item(W, 2048, WIN + (size_t)l * 2048 * DM, DM, kb * 64, nb * 32, nb * 32, scr, F_LANE, KIN(1) + (size_t)l * DM); continue; }
        const int q = it - NL * I_IN, l = q / I_OUT, r = q % I_OUT, kb = r / 32, nb = r % 32;
        const float* W = ((l & 1) ? KIN(12) : KIN(5)) + (size_t)(l >> 1) * DM * DM;
        p0_transpose_item(W, DM, WOUT + (size_t)l * DM * DM, DM, kb * 64, nb * 32, nb * 32, scr, F_LANE, nullptr);
    }
    {
        bf16_t* WSB = (bf16_t*)(F_WS + WS_WSB); bf16_t* PWT = (bf16_t*)(F_WS + WS_PWT);
        const int gt = F_BID * NTHR + F_TID, NGT = F_G * NTHR;
        for (int i = gt; i < 2 * 8 * 128 * 128; i += NGT) { const int jj = i & 127, ii = (i >> 7) & 127; const float v = (jj <= ii) ? KIN(10)[i] : 0.f; WSB[i] = (bf16_t)f2bf(v); }
        bf16_t* WRH = (bf16_t*)(F_WS + WS_WRT); bf16_t* WRL = WRH + NL * 80 * 1024;
        for (int i = gt; i < NL * 80 * 1024; i += NGT) { const int k = i & 1023, n = (i >> 10) % 80, l = i / 81920;
            const float w = (n < 8 ? KIN(13)[((size_t)l * 1024 + k) * 8 + n] : (n < 72 ? KIN(15)[((size_t)l * 1024 + k) * 64 + n - 8] : 0.f)) * KIN(2)[l * 1024 + k];
            const unsigned hi = f2bf(w); const float rem = w - bf_lo(hi);
            WRH[i] = (bf16_t)hi; WRL[i] = (bf16_t)f2bf(rem); }
        for (int i = gt; i < 2 * 4 * 128 * 128; i += NGT) { const int c = i & 127, d = (i >> 7) & 127, lg2 = i >> 14; PWT[i] = (bf16_t)f2bf(KIN(6)[(size_t)lg2 * 16384 + c * 128 + d]); }
    }
    bf16_t* XBz = (bf16_t*)(F_WS + WS_XB);
    for (int m = gw; m < NT; m += NGW) {
        const f32x4* xr = (const f32x4*)(KIN(0) + (size_t)m * DM) + F_LANE; f32x4 v[4];
#pragma unroll
        for (int j = 0; j < 4; ++j) { v[j] = xr[64 * j]; u32x2 w; w.x = cvt_pk_bf16(v[j].x, v[j].y); w.y = cvt_pk_bf16(v[j].z, v[j].w); *((u32x2*)((bf16_t*)(F_WS + WS_X16) + (size_t)m * DM) + F_LANE + 64 * j) = w; }
        row_rstd(v, F_LANE, (float*)(F_WS + WS_RSTD) + m);
    }
    if (gw == 0) { for (int j = 0; j < 4; ++j) *((u32x2*)(XBz + (size_t)ZERO_ROW * DM) + F_LANE + 64 * j) = (u32x2){0u, 0u}; }
}

typedef float f32x16 __attribute__((ext_vector_type(16)));
typedef short s16x4 __attribute__((ext_vector_type(4)));
constexpr int ATT_RS = 144;
constexpr int ATT_VBUF = 32 * ATT_RS;
__device__ __forceinline__ void attn_mfma(Frame& F, const Args& AR) {
    const bf16_t* Z = (const bf16_t*)(F_WS + WS_Z); bf16_t* YM = (bf16_t*)(F_WS + WS_YM);
    const int lane = F_LANE, l31 = lane & 31, hh = lane >> 5;
    LAS unsigned char* vbuf = F.lds + F_WAVE * (2 * ATT_VBUF);
    const int gi = (lane >> 4) & 1, q4 = (lane & 15) >> 2, p4 = lane & 3;
    const unsigned troff = (unsigned)((4 * hh + q4) * ATT_RS + (16 * gi + 4 * p4) * 2);
    const int vr8 = lane >> 3, vcol = lane & 7;
    const float SC = 0.125f * 1.4426950408889634f;
    const int NJOB = 2048, W0 = F_BID * NWAVES + F_WAVE, NW = F_G * NWAVES;
    for (int job = W0; job < NJOB; job += NW) {
        const int bh = job >> 5, b = bh >> 3, head = bh & 7, gp = (job >> 2) & 7, r = job & 3;
        for (int half = 0; half < 2; ++half) {
            const int g = half ? 15 - gp : gp;
            const int tq = b * SEQ + 128 * g + 4 * l31 + r;
            bf16x8 Qf[4];
#pragma unroll
            for (int s2 = 0; s2 < 4; ++s2) Qf[s2] = *(const bf16x8*)(Z + (size_t)tq * ZP + 512 + head * 64 + 16 * s2 + 8 * hh);
            f32x16 O0, O1;
#pragma unroll
            for (int i = 0; i < 16; ++i) { O0[i] = 0.f; O1[i] = 0.f; }
            float m = -INFINITY, l = 0.f;
            const int nA0 = (g == 0) ? 4 : 0, nA = 8 - nA0, nblk = nA + g + 1;
            bf16x8 Kn[4]; u32x4 Vn[4];
            { const int kstart = 128 * g - 128 + 32 * nA0;
              const bf16_t* kp = Z + (size_t)(b * SEQ + kstart + l31) * ZP + 1024 + head * 64 + 8 * hh;
#pragma unroll
              for (int s2 = 0; s2 < 4; ++s2) Kn[s2] = *(const bf16x8*)(kp + 16 * s2);
              const bf16_t* vp = Z + (size_t)(b * SEQ + kstart + vr8) * ZP + 1536 + head * 64 + 8 * vcol;
#pragma unroll
              for (int c4 = 0; c4 < 4; ++c4) Vn[c4] = *(const u32x4*)(vp + (size_t)c4 * 8 * ZP); }
            for (int n = 0; n < nblk; ++n) {
                const bool passA = n < nA;
                const int kstart = passA ? (128 * g - 128 + 32 * (nA0 + n)) : 32 * (n - nA);
                bf16x8 Kc[4];
#pragma unroll
                for (int s2 = 0; s2 < 4; ++s2) Kc[s2] = Kn[s2];
                LAS unsigned char* vb = vbuf + (n & 1) * ATT_VBUF;
#pragma unroll
                for (int c4 = 0; c4 < 4; ++c4) *(LAS u32x4*)(vb + (8 * c4 + vr8) * ATT_RS + vcol * 16) = Vn[c4];
                if (n + 1 < nblk) {
                    const int n1 = n + 1; const bool pA = n1 < nA;
                    const int ks1 = pA ? (128 * g - 128 + 32 * (nA0 + n1)) : 32 * (n1 - nA);
                    const int tk = pA ? (b * SEQ + ks1 + l31) : (b * SEQ + 4 * (ks1 + l31) + r);
                    const int tv = pA ? (b * SEQ + ks1 + vr8) : (b * SEQ + 4 * (ks1 + vr8) + r);
                    const bf16_t* kp = Z + (size_t)tk * ZP + 1024 + head * 64 + 8 * hh;
#pragma unroll
                    for (int s2 = 0; s2 < 4; ++s2) Kn[s2] = *(const bf16x8*)(kp + 16 * s2);
                    const bf16_t* vp = Z + (size_t)tv * ZP + 1536 + head * 64 + 8 * vcol; const size_t vstep = (size_t)(pA ? 8 : 32) * ZP;
#pragma unroll
                    for (int c4 = 0; c4 < 4; ++c4) Vn[c4] = *(const u32x4*)(vp + c4 * vstep);
                }
                f32x16 S;
#pragma unroll
                for (int i = 0; i < 16; ++i) S[i] = 0.f;
#pragma unroll
                for (int s2 = 0; s2 < 4; ++s2) S = __builtin_amdgcn_mfma_f32_32x32x16_bf16(Kc[s2], Qf[s2], S, 0, 0, 0);
                const int qpos = passA ? (128 * g + 4 * l31 + r) : (32 * g + l31);
                const int dbase = qpos - kstart - 4 * hh;
                float bm = -INFINITY; float P[16];
                if (passA) {
#pragma unroll
                    for (int i = 0; i < 16; ++i) { const int d = dbase - ((i & 3) + 8 * (i >> 2));
                        const float sv = ((unsigned)d <= 128u) ? S[i] * SC : -INFINITY; S[i] = sv; bm = fmaxf(bm, sv); }
                } else {
#pragma unroll
                    for (int i = 0; i < 16; ++i) { const int d = dbase - ((i & 3) + 8 * (i >> 2));
                        const bool v1 = (unsigned)d <= 128u, v2 = d >= 0 && (d & 3) == 0;
                        const float sv = (v1 || v2) ? S[i] * SC + ((v1 && v2) ? 1.0f : 0.0f) : -INFINITY; S[i] = sv; bm = fmaxf(bm, sv); }
                }
                bm = fmaxf(bm, __shfl_xor(bm, 32));
                if (__builtin_amdgcn_ballot_w64(bm > m) != 0ull) {
                    const float mnew = fmaxf(m, bm);
                    const float msafe0 = (mnew == -INFINITY) ? 0.f : mnew;
                    const float alpha = __builtin_amdgcn_exp2f(m - msafe0);
                    m = mnew; l *= alpha;
#pragma unroll
                    for (int i = 0; i < 16; ++i) { O0[i] *= alpha; O1[i] *= alpha; }
                }
                const float msafe = (m == -INFINITY) ? 0.f : m;
                float ps = 0.f;
#pragma unroll
                for (int i = 0; i < 16; ++i) { const float p = __builtin_amdgcn_exp2f(S[i] - msafe); P[i] = p; ps += p; }
                l += ps;
                bf16x8 Pf[2];
#pragma unroll
                for (int s2 = 0; s2 < 2; ++s2) {
                    u32x4 pk; pk.x = cvt_pk_bf16(P[8 * s2 + 0], P[8 * s2 + 1]); pk.y = cvt_pk_bf16(P[8 * s2 + 2], P[8 * s2 + 3]);
                    pk.z = cvt_pk_bf16(P[8 * s2 + 4], P[8 * s2 + 5]); pk.w = cvt_pk_bf16(P[8 * s2 + 6], P[8 * s2 + 7]);
                    Pf[s2] = __builtin_bit_cast(bf16x8, pk);
                }
                const unsigned va = (unsigned)(size_t)vb + troff;
                s16x4 v000, v001, v010, v011, v100, v101, v110, v111;
                asm volatile("s_waitcnt lgkmcnt(0)\n\t"
                             "ds_read_b64_tr_b16 %0, %8\n\t"
                             "ds_read_b64_tr_b16 %1, %8 offset:%9\n\t"
                             "ds_read_b64_tr_b16 %2, %8 offset:%10\n\t"
                             "ds_read_b64_tr_b16 %3, %8 offset:%11\n\t"
                             "ds_read_b64_tr_b16 %4, %8 offset:64\n\t"
                             "ds_read_b64_tr_b16 %5, %8 offset:%12\n\t"
                             "ds_read_b64_tr_b16 %6, %8 offset:%13\n\t"
                             "ds_read_b64_tr_b16 %7, %8 offset:%14\n\t"
                             "s_waitcnt lgkmcnt(0)"
                             : "=&v"(v000), "=&v"(v001), "=&v"(v010), "=&v"(v011), "=&v"(v100), "=&v"(v101), "=&v"(v110), "=&v"(v111)
                             : "v"(va), "n"(8 * ATT_RS), "n"(16 * ATT_RS), "n"(24 * ATT_RS), "n"(64 + 8 * ATT_RS), "n"(64 + 16 * ATT_RS), "n"(64 + 24 * ATT_RS)
                             : "memory");
                bf16x8 A00, A01, A10, A11;
                A00 = (bf16x8){v000[0], v000[1], v000[2], v000[3], v001[0], v001[1], v001[2], v001[3]};
                A01 = (bf16x8){v010[0], v010[1], v010[2], v010[3], v011[0], v011[1], v011[2], v011[3]};
                A10 = (bf16x8){v100[0], v100[1], v100[2], v100[3], v101[0], v101[1], v101[2], v101[3]};
                A11 = (bf16x8){v110[0], v110[1], v110[2], v110[3], v111[0], v111[1], v111[2], v111[3]};
                O0 = __builtin_amdgcn_mfma_f32_32x32x16_bf16(A00, Pf[0], O0, 0, 0, 0);
                O0 = __builtin_amdgcn_mfma_f32_32x32x16_bf16(A01, Pf[1], O0, 0, 0, 0);
                O1 = __builtin_amdgcn_mfma_f32_32x32x16_bf16(A10, Pf[0], O1, 0, 0, 0);
                O1 = __builtin_amdgcn_mfma_f32_32x32x16_bf16(A11, Pf[1], O1, 0, 0, 0);
            }
            l += __shfl_xor(l, 32);
            const float inv = 1.0f / l;
            bf16_t* op = YM + (size_t)tq * DM + 512 + head * 64 + 4 * hh;
#pragma unroll
            for (int k4 = 0; k4 < 4; ++k4) {
                u32x2 w0, w1;
                w0.x = cvt_pk_bf16(O0[4 * k4 + 0] * inv, O0[4 * k4 + 1] * inv); w0.y = cvt_pk_bf16(O0[4 * k4 + 2] * inv, O0[4 * k4 + 3] * inv);
                w1.x = cvt_pk_bf16(O1[4 * k4 + 0] * inv, O1[4 * k4 + 1] * inv); w1.y = cvt_pk_bf16(O1[4 * k4 + 2] * inv, O1[4 * k4 + 3] * inv);
                *(u32x2*)(op + 8 * k4) = w0; *(u32x2*)(op + 32 + 8 * k4) = w1;
            }
        }
    }
    __syncthreads();
}
constexpr int SGU_RS = 272;
__device__ __forceinline__ void sgu_mfma(Frame& F, const Args& AR, int li) {
    const bf16_t* Z = (const bf16_t*)(F_WS + WS_Z); bf16_t* YM = (bf16_t*)(F_WS + WS_YM); const float* VS = (const float*)(F_WS + WS_VSTAT);
    const bf16_t* WSB = (const bf16_t*)(F_WS + WS_WSB) + (size_t)li * 8 * 16384;
    const float* GN = KIN(9) + (size_t)li * DM; const float* BS = KIN(11) + (size_t)li * 8 * 128;
    constexpr int IMG = 128 * SGU_RS;
    const int tid = F_TID, lane = tid & 63, wave = __builtin_amdgcn_readfirstlane(tid >> 6);
    const int l31 = lane & 31, hh = lane >> 5, gi2 = (lane >> 4) & 1, q4 = (lane & 15) >> 2, p4 = lane & 3;
    const int ct = wave & 3, ia = wave >> 2;
    const int sj = tid >> 2, sc0 = (tid & 3) * 32;
    u32x4 sp[4]; f32x2 sst[4];
#define SGU_LOAD(unit_) do { const int _bn = (unit_) >> 3, _g = (unit_) & 7, _tok = _bn * 128 + sj; \
        const f32x2* _st = (const f32x2*)(VS + (size_t)_tok * 32) + (tid & 3) * 4; \
        _Pragma("unroll") for (int _i = 0; _i < 4; ++_i) sst[_i] = _st[_i]; \
        const u32x4* _p = (const u32x4*)(Z + (size_t)_tok * ZP + 1024 + _g * 128 + sc0); \
        _Pragma("unroll") for (int _k = 0; _k < 4; ++_k) sp[_k] = _p[_k]; } while (0)
#define SGU_STORE(unit_, buf_) do { const int _g = (unit_) & 7; float sm = 0.f, sq = 0.f; \
        _Pragma("unroll") for (int _i = 0; _i < 4; ++_i) { sm += sst[_i].x; sq += sst[_i].y; } \
        sm += __shfl_xor(sm, 1); sm += __shfl_xor(sm, 2); sq += __shfl_xor(sq, 1); sq += __shfl_xor(sq, 2); \
        const float mean = sm * (1.f / DM), rstd = 1.0f / sqrtf(sq * (1.f / DM) - mean * mean + EPS); \
        const f32x4* gp4 = (const f32x4*)(GN + _g * 128 + sc0); \
        _Pragma("unroll") for (int _k = 0; _k < 4; ++_k) { const u32x4 a = sp[_k]; const f32x4 g0 = gp4[2 * _k], g1 = gp4[2 * _k + 1]; u32x4 w; \
            w.x = cvt_pk_bf16((bf_lo(a.x) - mean) * rstd * g0.x, (bf_hi(a.x) - mean) * rstd * g0.y); w.y = cvt_pk_bf16((bf_lo(a.y) - mean) * rstd * g0.z, (bf_hi(a.y) - mean) * rstd * g0.w); \
            w.z = cvt_pk_bf16((bf_lo(a.z) - mean) * rstd * g1.x, (bf_hi(a.z) - mean) * rstd * g1.y); w.w = cvt_pk_bf16((bf_lo(a.w) - mean) * rstd * g1.z, (bf_hi(a.w) - mean) * rstd * g1.w); \
            *(LAS u32x4*)(F.lds + (buf_) * IMG + sj * SGU_RS + sc0 * 2 + 16 * _k) = w; } } while (0)
    __syncthreads();
    int unit = F_BID, par = 0;
    const bool wlds = (F_G % 8 == 0);
    LAS unsigned char* wtile = F.lds + 2 * IMG;
    if (wlds) { const bf16_t* wsrc = WSB + (size_t)(F_BID & 7) * 16384; u32x4 wv[4];
#pragma unroll
        for (int k = 0; k < 4; ++k) wv[k] = *(const u32x4*)(wsrc + (size_t)((tid >> 4) + 32 * k) * 128 + (tid & 15) * 8);
#pragma unroll
        for (int k = 0; k < 4; ++k) *(LAS u32x4*)(wtile + ((tid >> 4) + 32 * k) * SGU_RS + (tid & 15) * 16) = wv[k]; }
    if (unit < 1024) { SGU_LOAD(unit); SGU_STORE(unit, 0); }
    __syncthreads();
    for (; unit < 1024; unit += F_G, par ^= 1) {
        const int nxt = unit + F_G;
        if (nxt < 1024) SGU_LOAD(nxt);
        const int bn = unit >> 3, g = unit & 7, tok0 = bn * 128;
        LAS unsigned char* vimg = F.lds + par * IMG;
        bf16x8 Bf[2][8]; u32x2 uu[2][4]; float bsv[2];
#pragma unroll
        for (int ib = 0; ib < 2; ++ib) {
            const int it = 2 * ia + ib;
            const int ns = 2 * it + 2;
            const bf16_t* wrow = WSB + (size_t)g * 16384 + (size_t)(32 * it + l31) * 128 + 8 * hh;
#pragma unroll
            for (int s2 = 0; s2 < 8; ++s2) if (s2 < ns) { if (wlds) Bf[ib][s2] = *(const LAS bf16x8*)(wtile + (32 * it + l31) * SGU_RS + (16 * s2 + 8 * hh) * 2); else Bf[ib][s2] = *(const bf16x8*)(wrow + 16 * s2); }
            const int i = 32 * it + l31, tok = tok0 + i; bsv[ib] = BS[g * 128 + i];
            const bf16_t* up = Z + (size_t)tok * ZP + g * 128 + 32 * ct + 4 * hh;
#pragma unroll
            for (int k4 = 0; k4 < 4; ++k4) uu[ib][k4] = *(const u32x2*)(up + 8 * k4);
        }
#pragma unroll
        for (int ib = 0; ib < 2; ++ib) {
            const int it = 2 * ia + ib, ns = 2 * it + 2;
            const int i = 32 * it + l31, tok = tok0 + i;
            bf16_t* op = YM + (size_t)tok * DM + g * 128 + 32 * ct + 4 * hh;
            f32x16 C;
#pragma unroll
            for (int q = 0; q < 16; ++q) C[q] = 0.f;
            const unsigned va = (unsigned)(size_t)vimg + (unsigned)((8 * hh + q4) * SGU_RS + (32 * ct + 16 * gi2 + 4 * p4) * 2);
#pragma unroll
            for (int s4 = 0; s4 < 4; ++s4) {
                if (2 * s4 < ns) {
                    s16x4 t0, t1, t2, t3;
                    asm volatile("ds_read_b64_tr_b16 %0, %4\n\tds_read_b64_tr_b16 %1, %4 offset:%5\n\tds_read_b64_tr_b16 %2, %4 offset:%6\n\tds_read_b64_tr_b16 %3, %4 offset:%7\n\ts_waitcnt lgkmcnt(0)"
                                 : "=&v"(t0), "=&v"(t1), "=&v"(t2), "=&v"(t3) : "v"(va + (unsigned)(32 * s4 * SGU_RS)), "n"(4 * SGU_RS), "n"(16 * SGU_RS), "n"(20 * SGU_RS) : "memory");
                    const bf16x8 A0 = (bf16x8){t0[0], t0[1], t0[2], t0[3], t1[0], t1[1], t1[2], t1[3]};
                    const bf16x8 A1 = (bf16x8){t2[0], t2[1], t2[2], t2[3], t3[0], t3[1], t3[2], t3[3]};
                    C = __builtin_amdgcn_mfma_f32_32x32x16_bf16(A0, Bf[ib][2 * s4], C, 0, 0, 0);
                    C = __builtin_amdgcn_mfma_f32_32x32x16_bf16(A1, Bf[ib][2 * s4 + 1], C, 0, 0, 0);
                }
            }
            const float bv = bsv[ib];
#pragma unroll
            for (int k4 = 0; k4 < 4; ++k4) { u32x2 w;
                w.x = cvt_pk_bf16(bf_lo(uu[ib][k4].x) * (C[4 * k4 + 0] + bv), bf_hi(uu[ib][k4].x) * (C[4 * k4 + 1] + bv)); w.y = cvt_pk_bf16(bf_lo(uu[ib][k4].y) * (C[4 * k4 + 2] + bv), bf_hi(uu[ib][k4].y) * (C[4 * k4 + 3] + bv));
                *(u32x2*)(op + 8 * k4) = w; }
        }
        if (nxt < 1024) SGU_STORE(nxt, par ^ 1);
        __syncthreads();
    }
#undef SGU_LOAD
#undef SGU_STORE
}
template <int W>
__device__ __forceinline__ void pool_window(const bf16_t* zp, int t, bf16x8 (&Bf)[8]) {
    const int cntw = (t + 1) < W ? (t + 1) : W; const float inv = 1.0f / (float)cntw;
#pragma unroll
    for (int s2 = 0; s2 < 8; ++s2) {
        u32x4 a[W];
#pragma unroll
        for (int j = 0; j < W; ++j) { const int jj = j < cntw ? j : 0; a[j] = *(const u32x4*)(zp - (size_t)jj * ZP + 16 * s2); }
        float acc[8];
#pragma unroll
        for (int i = 0; i < 8; ++i) acc[i] = 0.f;
#pragma unroll
        for (int j = 0; j < W; ++j) { const float m = j < cntw ? 1.f : 0.f;
            acc[0] += m * bf_lo(a[j].x); acc[1] += m * bf_hi(a[j].x); acc[2] += m * bf_lo(a[j].y); acc[3] += m * bf_hi(a[j].y);
            acc[4] += m * bf_lo(a[j].z); acc[5] += m * bf_hi(a[j].z); acc[6] += m * bf_lo(a[j].w); acc[7] += m * bf_hi(a[j].w); }
        const float s0 = bf_lo(a[0].x), s1 = bf_hi(a[0].x), s2f = bf_lo(a[0].y), s3 = bf_hi(a[0].y), s4 = bf_lo(a[0].z), s5 = bf_hi(a[0].z), s6 = bf_lo(a[0].w), s7 = bf_hi(a[0].w);
        u32x4 pk; pk.x = cvt_pk_bf16(acc[0] * inv - s0, acc[1] * inv - s1); pk.y = cvt_pk_bf16(acc[2] * inv - s2f, acc[3] * inv - s3);
        pk.z = cvt_pk_bf16(acc[4] * inv - s4, acc[5] * inv - s5); pk.w = cvt_pk_bf16(acc[6] * inv - s6, acc[7] * inv - s7);
        Bf[s2] = __builtin_bit_cast(bf16x8, pk);
    }
}
constexpr int POOL_RS = 272;
constexpr int POOL_TILE = 48 * POOL_RS;
template <int W>
__device__ __forceinline__ void pool_window_lds(const bf16_t* Zg, int tok0, int lane, LAS unsigned char* tile, bf16x8 (&Bf)[8]) {
    constexpr int NR = 32 + W - 1, NI = (NR + 3) / 4;
    const int rr = lane >> 4, cc = lane & 15;
    u32x4 st[NI];
#pragma unroll
    for (int i = 0; i < NI; ++i) { const int r = 4 * i + rr; int tk = tok0 - (W - 1) + r; tk = tk < 0 ? 0 : tk; tk = tk > NT - 1 ? NT - 1 : tk;
        st[i] = *(const u32x4*)(Zg + (size_t)tk * ZP + cc * 8); }
#pragma unroll
    for (int i = 0; i < NI; ++i) { const int r = 4 * i + rr; if (r < NR) *(LAS u32x4*)(tile + r * POOL_RS + cc * 16) = st[i]; }
    LDS_WAIT(); asm volatile("" ::: "memory");
    const int l31 = lane & 31, hh = lane >> 5, t = (tok0 + l31) % SEQ;
    const int cntw = (t + 1) < W ? (t + 1) : W; const float inv = 1.0f / (float)cntw;
    const LAS unsigned char* base = tile + (l31 + W - 1) * POOL_RS + hh * 16;
#pragma unroll
    for (int s2 = 0; s2 < 8; ++s2) {
        u32x4 a[W];
#pragma unroll
        for (int j = 0; j < W; ++j) a[j] = *(const LAS u32x4*)(base - j * POOL_RS + 32 * s2);
        float acc[8];
#pragma unroll
        for (int i = 0; i < 8; ++i) acc[i] = 0.f;
#pragma unroll
        for (int j = 0; j < W; ++j) { const float m = j < cntw ? 1.f : 0.f;
            acc[0] += m * bf_lo(a[j].x); acc[1] += m * bf_hi(a[j].x); acc[2] += m * bf_lo(a[j].y); acc[3] += m * bf_hi(a[j].y);
            acc[4] += m * bf_lo(a[j].z); acc[5] += m * bf_hi(a[j].z); acc[6] += m * bf_lo(a[j].w); acc[7] += m * bf_hi(a[j].w); }
        const float s0 = bf_lo(a[0].x), s1 = bf_hi(a[0].x), s2f = bf_lo(a[0].y), s3 = bf_hi(a[0].y), s4 = bf_lo(a[0].z), s5 = bf_hi(a[0].z), s6 = bf_lo(a[0].w), s7 = bf_hi(a[0].w);
        u32x4 pk; pk.x = cvt_pk_bf16(acc[0] * inv - s0, acc[1] * inv - s1); pk.y = cvt_pk_bf16(acc[2] * inv - s2f, acc[3] * inv - s3);
        pk.z = cvt_pk_bf16(acc[4] * inv - s4, acc[5] * inv - s5); pk.w = cvt_pk_bf16(acc[6] * inv - s6, acc[7] * inv - s7);
        Bf[s2] = __builtin_bit_cast(bf16x8, pk);
    }
}
__device__ __forceinline__ void pool_mfma(Frame& F, const Args& AR, int li) {
    const bf16_t* Z = (const bf16_t*)(F_WS + WS_Z); bf16_t* YM = (bf16_t*)(F_WS + WS_YM);
    const bf16_t* PWT = (const bf16_t*)(F_WS + WS_PWT) + (size_t)li * 4 * 16384; const float* PS = KIN(7) + (size_t)li * 512;
    const int lane = F_LANE, l31 = lane & 31, hh = lane >> 5;
    const int NJOB = 2048, W0 = F_BID * NWAVES + F_WAVE, NW = F_G * NWAVES;
    for (int job = W0; job < NJOB; job += NW) {
        const int g = job & 3, tile = job >> 2;
        const int tok = tile * 32 + l31, t = tok % SEQ;
        bf16x8 Bf[8];
        const bf16_t* Zg = Z + g * 128; LAS unsigned char* ptile = F.lds + F_WAVE * POOL_TILE;
        switch (__builtin_amdgcn_readfirstlane(g)) {
            case 0: pool_window_lds<2>(Zg, tile * 32, lane, ptile, Bf); break;
            case 1: pool_window_lds<4>(Zg, tile * 32, lane, ptile, Bf); break;
            case 2: pool_window_lds<8>(Zg, tile * 32, lane, ptile, Bf); break;
            default: pool_window_lds<16>(Zg, tile * 32, lane, ptile, Bf); break;
        }
#pragma unroll
        for (int dt = 0; dt < 4; ++dt) {
            f32x16 C;
#pragma unroll
            for (int i = 0; i < 16; ++i) C[i] = 0.f;
            const bf16_t* arow = PWT + (size_t)g * 16384 + (size_t)(32 * dt + l31) * 128 + 8 * hh;
#pragma unroll
            for (int s2 = 0; s2 < 8; ++s2) { const bf16x8 Af = *(const bf16x8*)(arow + 16 * s2); C = __builtin_amdgcn_mfma_f32_32x32x16_bf16(Af, Bf[s2], C, 0, 0, 0); }
            bf16_t* op = YM + (size_t)tok * DM + g * 128 + 32 * dt + 4 * hh; const float* ps = PS + g * 128 + 32 * dt + 4 * hh;
#pragma unroll
            for (int k4 = 0; k4 < 4; ++k4) { const f32x4 sc = *(const f32x4*)(ps + 8 * k4); u32x2 wv;
                wv.x = cvt_pk_bf16(C[4 * k4 + 0] * sc.x, C[4 * k4 + 1] * sc.y); wv.y = cvt_pk_bf16(C[4 * k4 + 2] * sc.z, C[4 * k4 + 3] * sc.w);
                *(u32x2*)(op + 8 * k4) = wv; }
        }
    }
}
typedef float f32x4v __attribute__((ext_vector_type(4)));
__device__ __forceinline__ void router_mfma(Frame& F, const Args& AR, int layer) {
    const bf16_t* WRH = (const bf16_t*)(F_WS + WS_WRT) + (size_t)layer * 80 * 1024; const bf16_t* WRL = WRH + NL * 80 * 1024; const bf16_t* XBp = (const bf16_t*)(F_WS + WS_XB);
    const float* GB = KIN(14) + layer * 8; const float* EB = KIN(16) + layer * 64; const float* gn = KIN(2) + (size_t)layer * DM;
    i32x4* list = (i32x4*)(F_WS + WS_LIST); i32x4* tinfo = (i32x4*)(F_WS + WS_TOKINFO);
    unsigned* cnt = F_CTL + CW_CNT + layer * NE * 64;
    LAS float* part = (LAS float*)(F.lds);
    LAS float* lg = (LAS float*)(F.lds + 90112);
    LAS float* rs = (LAS float*)(F.lds + 90112 + 20992);
    LAS unsigned* lcnt = (LAS unsigned*)(F.lds + 90112 + 20992 + 256);
    const int lane = F_LANE, a_tok = lane & 15, kq = lane >> 4, w = F_WAVE;
    for (int unit = F_BID; unit < NT / 64; unit += F_G) {
        const int tokb = unit * 64;
        f32x4 acc[4][5]; float ss[4];
#pragma unroll
        for (int t = 0; t < 4; ++t) { ss[t] = 0.f;
#pragma unroll
            for (int nt = 0; nt < 5; ++nt) acc[t][nt] = (f32x4){0.f, 0.f, 0.f, 0.f}; }
        const unsigned woff = (unsigned)((a_tok * 1024 + w * 128 + 8 * kq) * 2), xoff = (unsigned)(((tokb + a_tok) * DM + w * 128 + 8 * kq) * 2);
        const GAS char* whb[5]; const GAS char* wlb[5]; const GAS char* xb = (const GAS char*)XBp;
#pragma unroll
        for (int nt = 0; nt < 5; ++nt) { whb[nt] = (const GAS char*)WRH + nt * 32768; wlb[nt] = (const GAS char*)WRL + nt * 32768; asm volatile("" : "+s"(whb[nt]), "+s"(wlb[nt])); }
        bf16x8 wh[2][5], wl[2][5]; u32x4 xv[2][4];
#define R_LOAD(b, j) { _Pragma("unroll") for (int nt = 0; nt < 5; ++nt) { wh[b][nt] = *(const GAS bf16x8*)(whb[nt] + 64 * (j) + woff); wl[b][nt] = *(const GAS bf16x8*)(wlb[nt] + 64 * (j) + woff); } \
                       _Pragma("unroll") for (int t = 0; t < 4; ++t) xv[b][t] = *(const GAS u32x4*)(xb + (t * 16 * DM * 2 + 64 * (j)) + xoff); }
#define R_COMP(b) { _Pragma("unroll") for (int t = 0; t < 4; ++t) { const u32x4 xr4 = xv[b][t]; \
                { const float x0 = bf_lo(xr4.x), x1 = bf_hi(xr4.x), x2 = bf_lo(xr4.y), x3 = bf_hi(xr4.y), x4 = bf_lo(xr4.z), x5 = bf_hi(xr4.z), x6 = bf_lo(xr4.w), x7 = bf_hi(xr4.w); \
                  ss[t] += ((x0 * x0 + x1 * x1) + (x2 * x2 + x3 * x3)) + ((x4 * x4 + x5 * x5) + (x6 * x6 + x7 * x7)); } \
                const bf16x8 xa = __builtin_bit_cast(bf16x8, xr4); \
                _Pragma("unroll") for (int nt = 0; nt < 5; ++nt) { acc[t][nt] = __builtin_amdgcn_mfma_f32_16x16x32_bf16(xa, wh[b][nt], acc[t][nt], 0, 0, 0); acc[t][nt] = __builtin_amdgcn_mfma_f32_16x16x32_bf16(xa, wl[b][nt], acc[t][nt], 0, 0, 0); } } }
        R_LOAD(0, 0); R_LOAD(1, 1); __builtin_amdgcn_sched_barrier(0);
        R_COMP(0); __builtin_amdgcn_sched_barrier(0); R_LOAD(0, 2); __builtin_amdgcn_sched_barrier(0);
        R_COMP(1); __builtin_amdgcn_sched_barrier(0); R_LOAD(1, 3); __builtin_amdgcn_sched_barrier(0);
        R_COMP(0); R_COMP(1);
#undef R_LOAD
#undef R_COMP
#pragma unroll
        for (int t = 0; t < 4; ++t) { ss[t] += __shfl_xor(ss[t], 16); ss[t] += __shfl_xor(ss[t], 32); }
#pragma unroll
        for (int half = 4; half >= 1; half >>= 1) {
            __syncthreads();
            if (w >= half && w < 2 * half) { LAS f32x4* p = (LAS f32x4*)part + (size_t)(w - half) * (21 * 64) + lane;
#pragma unroll
                for (int t = 0; t < 4; ++t) {
#pragma unroll
                    for (int nt = 0; nt < 5; ++nt) p[(t * 5 + nt) * 64] = acc[t][nt]; }
                p[20 * 64] = (f32x4){ss[0], ss[1], ss[2], ss[3]}; }
            __syncthreads();
            if (w < half) { const LAS f32x4* p = (const LAS f32x4*)part + (size_t)w * (21 * 64) + lane;
#pragma unroll
                for (int t = 0; t < 4; ++t) {
#pragma unroll
                    for (int nt = 0; nt < 5; ++nt) acc[t][nt] += p[(t * 5 + nt) * 64]; }
                const f32x4 s4 = p[20 * 64]; ss[0] += s4.x; ss[1] += s4.y; ss[2] += s4.z; ss[3] += s4.w; }
        }
        if (w == 0) {
            const int l2 = F_LANE, a2 = l2 & 15, k2 = l2 >> 4;
#pragma unroll
            for (int t = 0; t < 4; ++t) { const float rstd = 1.0f / sqrtf(ss[t] * (1.f / DM) + EPS); if (k2 == 0) rs[t * 16 + a2] = rstd; }
            LDS_WAIT(); asm volatile("" ::: "memory");
            LAS float* lgb = lg + k2 * 324 + a2; const LAS float* rsb = rs + 4 * k2;
#pragma unroll
            for (int nt = 0; nt < 5; ++nt) { const int n = 16 * nt + a2; const float bias = n < 8 ? GB[n] : (n < 72 ? EB[n - 8] : 0.f);
#pragma unroll
                for (int t = 0; t < 4; ++t) {
#pragma unroll
                    for (int rg = 0; rg < 4; ++rg) lgb[(t * 16 + rg) * 81 + 16 * nt] = acc[t][nt][rg] * rsb[t * 16 + rg] + bias; } }
        }
        __syncthreads();
        int x1 = 0, x2 = 0; unsigned r1 = 0, r2 = 0; float g1 = 0.f, g2 = 0.f;
        if (F_TID < 64) lcnt[F_TID] = 0u;
        __syncthreads();
        if (F_TID < 64) {
            const LAS float* L = lg + F_TID * 81;
            float m = L[0]; int gi = 0;
            for (int i = 1; i < 8; ++i) if (L[i] > m) { m = L[i]; gi = i; }
            float s = 0.f; for (int i = 0; i < 8; ++i) s += __expf(L[i] - m);
            const float gp = 1.0f / s;
            const LAS float* E = L + 8 + gi * 8;
            float t1 = E[0]; int i1 = 0;
            for (int i = 1; i < 8; ++i) if (E[i] > t1) { t1 = E[i]; i1 = i; }
            float t2 = -INFINITY; int i2 = 0;
            for (int i = 0; i < 8; ++i) if (i != i1 && E[i] > t2) { t2 = E[i]; i2 = i; }
            const float e2 = __expf(t2 - t1); const float p1 = 1.0f / (1.0f + e2), p2 = e2 / (1.0f + e2);
            x1 = gi * 8 + i1; x2 = gi * 8 + i2; g1 = gp * p1; g2 = gp * p2;
            r1 = __hip_atomic_fetch_add(lcnt + x1, 1u, __ATOMIC_RELAXED, __HIP_MEMORY_SCOPE_WORKGROUP);
            r2 = __hip_atomic_fetch_add(lcnt + x2, 1u, __ATOMIC_RELAXED, __HIP_MEMORY_SCOPE_WORKGROUP);
        }
        __syncthreads();
        if (F_TID < 64) { const unsigned c = lcnt[F_TID]; unsigned base = 0u;
            if (c) base = __hip_atomic_fetch_add(cnt + F_TID * 64, c, __ATOMIC_RELAXED, __HIP_MEMORY_SCOPE_AGENT);
            lcnt[F_TID] = base; }
        __syncthreads();
        if (F_TID < 64) {
            const int tok = tokb + F_TID; const int pos1 = (int)(lcnt[x1] + r1), pos2 = (int)(lcnt[x2] + r2);
            const int rsi = __float_as_int(rs[F_TID]);
            list[(size_t)x1 * NT + pos1] = (i32x4){tok, __float_as_int(g1), rsi, 0};
            list[(size_t)x2 * NT + pos2] = (i32x4){tok, __float_as_int(g2), rsi, 0};
            tinfo[tok] = (i32x4){x1, pos1, x2, pos2};
        }
    }
    __syncthreads();
}
__device__ __forceinline__ void combine_phase(Frame& F, const Args& AR, int layer, bool have_seg) {
    const MoeTabs T = moe_tabs(F);
    if (!have_seg) moe_build_seg(F, AR, T, layer);
    const bf16_t* Y = (const bf16_t*)(F_WS + WS_YMOE); const i32x4* tinfo = (const i32x4*)(F_WS + WS_TOKINFO);
    const bool lastl = (layer == NL - 1);
    const float* gn = lastl ? KIN(3) : KIN(1) + (size_t)(layer + 1) * DM;
    const int gw = F_BID * NWAVES + F_WAVE, NGW = F_G * NWAVES;
    for (int m0 = gw; m0 < NT; m0 += 2 * NGW) {
        const int m1 = m0 + NGW; const bool two = m1 < NT;
        const i32x4 ti0 = tinfo[m0]; i32x4 ti1 = ti0; if (two) ti1 = tinfo[m1];
        u32x2 ya[2][4], yb[2][4], xv[2][4];
#pragma unroll
        for (int q = 0; q < 2; ++q) {
            const i32x4 ti = q ? ti1 : ti0; const int m = q ? (two ? m1 : m0) : m0;
            const int ra = T.seg[ti.x] + ti.y, rb = T.seg[ti.z] + ti.w;
            const u32x2* xi = (const u32x2*)((const bf16_t*)(F_WS + WS_XB) + (size_t)m * DM) + F_LANE; const u32x2* pa = (const u32x2*)(Y + (size_t)ra * DM) + F_LANE; const u32x2* pb = (const u32x2*)(Y + (size_t)rb * DM) + F_LANE;
#pragma unroll
            for (int j = 0; j < 4; ++j) { ya[q][j] = pa[64 * j]; yb[q][j] = pb[64 * j]; xv[q][j] = xi[64 * j]; }
        }
#pragma unroll
        for (int q = 0; q < 2; ++q) {
            if (q == 1 && !two) break;
            const int m = q ? m1 : m0;
            u32x2* xr = (u32x2*)((bf16_t*)(F_WS + WS_X16) + (size_t)m * DM) + F_LANE;
            f32x4 v[4];
#pragma unroll
            for (int j = 0; j < 4; ++j) { const u32x2 a = ya[q][j], b = yb[q][j]; const u32x2 xx = xv[q][j]; f32x4 x = (f32x4){bf_lo(xx.x), bf_hi(xx.x), bf_lo(xx.y), bf_hi(xx.y)};
#ifndef DBG_NO_MOE
                x.x += bf_lo(a.x) + bf_lo(b.x); x.y += bf_hi(a.x) + bf_hi(b.x); x.z += bf_lo(a.y) + bf_lo(b.y); x.w += bf_hi(a.y) + bf_hi(b.y);
#endif
                v[j] = x; }
            if (lastl) norm_row(v, gn, F_LANE, nullptr, F_X + (size_t)m * DM);
            else {
#pragma unroll
                for (int j = 0; j < 4; ++j) { u32x2 w; w.x = cvt_pk_bf16(v[j].x, v[j].y); w.y = cvt_pk_bf16(v[j].z, v[j].w); xr[64 * j] = w; }
                row_rstd(v, F_LANE, (float*)(F_WS + WS_RSTD) + m);
            }
        }
    }
}

constexpr int NPH = 1 + NL * 7;
#ifndef PH_MASK
#define PH_MASK 0xFF
#endif
#define EN(b) (((PH_MASK) >> (b)) & 1)
#ifndef REP_MASK
#define REP_MASK 0
#endif
#define REPS(b) (1 + (((REP_MASK) >> (b)) & 1))
#define IN(k) (AR.ph_lo <= (k) && (k) < AR.ph_hi)
#define SEAM(k) do { if (IN((k) + 1)) { XcdBarrier _b; _b.bar = F_CTL + CW_BAR; _b.x = xb_xcc_id(); _b.st = (volatile LAS unsigned*)(F.lds + MISC_OFF + MO_BAR); xcd_barrier(_b); } } while (0)

template <int layer>
__device__ __forceinline__ void layer_phases(Frame& F, const Args& AR) {
    constexpr int pb = 1 + layer * 7; constexpr int li = layer >> 1; constexpr bool odd = (layer & 1) != 0;
    if (EN(0) && IN(pb + 0)) {
        pg8::PlainSched S; S.init(F_WS + WS_X16, F_WS + WS_WIN + (size_t)layer * 2048 * DM * 2, NT, 2048, DM, F_G, F_BID);
        pg8::EpiZ<odd> E{(bf16_t*)(F_WS + WS_Z), (float*)(F_WS + WS_VSTAT), (const float*)(F_WS + WS_RSTD)}; for (int rep = 0; rep < REPS(0); ++rep) pg8::gemm_phase<pg8::EpiZ<odd>, pg8::PlainSched, true>(F.lds, DM, S, E);
        SEAM(pb + 0);
    }
    if (EN(1) && IN(pb + 1)) {
        for (int rep = 0; rep < REPS(1); ++rep) { if (!odd) { for (int r2 = 0; r2 < REPS(8); ++r2) attn_mfma(F, AR); for (int r2 = 0; r2 < REPS(9); ++r2) pool_mfma(F, AR, li); } else { for (int r2 = 0; r2 < REPS(10); ++r2) sgu_mfma(F, AR, li); } }
        SEAM(pb + 1);
    }
    if (EN(2) && IN(pb + 2)) {
        pg8::PlainSched S; S.init(F_WS + WS_YM, F_WS + WS_WOUT + (size_t)layer * DM * DM * 2, NT, DM, DM, F_G, F_BID);
        pg8::EpiResid E{(const bf16_t*)(F_WS + WS_X16), (bf16_t*)(F_WS + WS_XB)}; for (int rep = 0; rep < REPS(2); ++rep) pg8::gemm_phase<pg8::EpiResid, pg8::PlainSched, false>(F.lds, DM, S, E);
        SEAM(pb + 2);
    }
    if (EN(3) && IN(pb + 3)) { router_mfma(F, AR, layer); SEAM(pb + 3); }
    if (EN(4) && IN(pb + 4)) {
        const MoeTabs T = moe_tabs(F);
        moe_build_seg(F, AR, T, layer);
        const int nfull = __builtin_amdgcn_readfirstlane(T.fst[NE]), total = nfull + __builtin_amdgcn_readfirstlane(T.hst[NE]);
        const bool fusedM = EN(5) && IN(pb + 5) && moe_fusable(nfull, total, F_G);
        for (int rep = 0; rep < REPS(4); ++rep)
        for (int base = 0; base < total; base += MAXU * F_G) {
            int nfw; const int nu = moe_build_units(F, AR, T, layer, base, true, nfull, total, false, nfw);
            pg4::gemm4_phase<0, 32, DE>(F.lds, T.tab, T.toks, T.rstd, (const char*)(F_WS + WS_XB), KIN(17), KIN(18), KIN(2) + (size_t)layer * DM, (bf16_t*)(F_WS + WS_HMOE), layer, nu);
            __syncthreads();
            if (fusedM && rep == 0) moe_publish(F, AR, T, layer, nu);
        }
        if (!fusedM) SEAM(pb + 4);
    }
    if (EN(5) && IN(pb + 5)) {
        const MoeTabs T = moe_tabs(F);
        const bool have = EN(4) && IN(pb + 4);
        if (!have) moe_build_seg(F, AR, T, layer);
        const int nfull = __builtin_amdgcn_readfirstlane(T.fst[NE]), total = nfull + __builtin_amdgcn_readfirstlane(T.hst[NE]);
        const bool fusedM = have && moe_fusable(nfull, total, F_G);
        const bool reuse = have && !fusedM && total <= MAXU * F_G;
        for (int rep = 0; rep < REPS(5); ++rep)
        for (int base = 0; base < total; base += MAXU * F_G) {
            int nfw; const int nu = moe_build_units(F, AR, T, layer, base, !reuse && !fusedM, nfull, total, fusedM, nfw);
            if (!fusedM) nfw = nu;
#pragma nounroll
            for (int part = 0; part < 2; ++part) { const int s0 = part ? nfw : 0, s1 = part ? nu : nfw;
                if (s1 > s0) {
                    if (fusedM && part) { int dummy; (void)moe_build_units(F, AR, T, layer, base, true, nfull, total, true, dummy, nfw); }
                    if (fusedM) moe_wait(F, AR, T, layer, s0, s1);
                    pg4::gemm4_phase<1, 16, DM>(F.lds, T.tab + s0 * 8, T.toks + s0 * 256, T.gates + s0 * 256, (const char*)(F_WS + WS_HMOE), KIN(19), KIN(19), nullptr, (bf16_t*)(F_WS + WS_YMOE), layer, s1 - s0);
                    __syncthreads(); } }
        }
        SEAM(pb + 5);
    }
        if (EN(6) && IN(pb + 6)) { for (int rep = 0; rep < REPS(6); ++rep) combine_phase(F, AR, layer, (EN(4) && IN(pb + 4)) || (EN(5) && IN(pb + 5)));
    if (layer + 1 < NL) SEAM(pb + 6); }
}

__global__ void __launch_bounds__(NTHR, 2) fwd_kernel(Args AR) {
    extern __shared__ __attribute__((aligned(16))) unsigned char lds_raw[];
    Frame F;
    F.lds = (LAS unsigned char*)lds_raw;
    for (int u = F_TID; u < (LDS_BYTES - MISC_OFF) / 4; u += NTHR) ((LAS unsigned*)(F.lds + MISC_OFF))[u] = 0u;
    __syncthreads();
    if (AR.ph_hi - AR.ph_lo > 1) (void)xcd_barrier_post(F_CTL + CW_BAR, (volatile LAS unsigned*)(F.lds + MISC_OFF + MO_BAR));

    if (EN(7) && IN(0)) { for (int rep = 0; rep < REPS(7); ++rep) p0_prologue(F, AR); SEAM(0); }
    layer_phases<0>(F, AR);
    layer_phases<1>(F, AR);
    layer_phases<2>(F, AR);
    layer_phases<3>(F, AR);
}
#undef IN
#undef SEAM

extern "C" void kernel_launch(void* const* d_in, const int* in_sizes, int n_in, void* d_out, int out_size, void* d_ws, size_t ws_size, hipStream_t stream) {
    static int grid = 0;
    if (grid == 0) {
        if (n_in != 20 || out_size != NT * DM || ws_size < WS_END) { fprintf(stderr, "kernel_launch: unexpected problem (n_in %d out %d ws %zu)\n", n_in, out_size, ws_size); grid = -1; return; }
        int dev = 0, cus = 0, per_cu = 0;
        if (hipGetDevice(&dev) != hipSuccess || hipDeviceGetAttribute(&cus, hipDeviceAttributeMultiprocessorCount, dev) != hipSuccess) { grid = -1; return; }
        if (hipFuncSetAttribute((const void*)fwd_kernel, hipFuncAttributeMaxDynamicSharedMemorySize, LDS_BYTES) != hipSuccess) { fprintf(stderr, "kernel_launch: hipFuncSetAttribute failed\n"); grid = -1; return; }
        if (hipOccupancyMaxActiveBlocksPerMultiprocessor(&per_cu, (const void*)fwd_kernel, NTHR, LDS_BYTES) != hipSuccess || per_cu < 1) fprintf(stderr, "kernel_launch: occupancy query says %d\n", per_cu);
        (void)hipGetLastError();
        grid = cus;
    }
    if (grid < 0) return;
    (void)hipMemsetAsync((char*)d_ws + WS_CTL, 0, CTL_ZERO_BYTES, stream);
    Args a{};
    for (int i = 0; i < 20; ++i) a.in[i] = (const float*)d_in[i];
    a.out = (float*)d_out; a.ws = (unsigned char*)d_ws;
#if MK_ONE_LAUNCH
    a.ph_lo = 0; a.ph_hi = NPH;
    hipLaunchKernelGGL(fwd_kernel, dim3(grid), dim3(NTHR), LDS_BYTES, stream, a);
#else
    for (int p = 0; p < NPH; ++p) { a.ph_lo = p; a.ph_hi = p + 1; hipLaunchKernelGGL(fwd_kernel, dim3(grid), dim3(NTHR), LDS_BYTES, stream, a); }
#endif
}
```

```cpp
#include <hip/hip_runtime.h>
#include <cstdio>
#include <cstdint>

#ifndef MK_ONE_LAUNCH
#define MK_ONE_LAUNCH 1
#endif

#define LAS __attribute__((address_space(3)))
#define GAS __attribute__((address_space(1)))
typedef unsigned short bf16_t;
typedef short bf16x8 __attribute__((ext_vector_type(8)));
typedef float f32x4 __attribute__((ext_vector_type(4)));
typedef float f32x2 __attribute__((ext_vector_type(2)));
typedef unsigned u32x4 __attribute__((ext_vector_type(4)));
typedef unsigned u32x2 __attribute__((ext_vector_type(2)));
typedef int i32x4 __attribute__((ext_vector_type(4)));
typedef int i32x2 __attribute__((ext_vector_type(2)));

constexpr int NT = 16384, DM = 1024, SEQ = 2048, NL = 4, NE = 64, DE = 512;
constexpr int NWAVES = 8, NTHR = 512;
constexpr float EPS = 1e-6f;
constexpr int ZP = 2048 + 64;
constexpr int ZERO_ROW = NT;
constexpr int NR_ALLOC = 42496;

constexpr size_t MiB = 1u << 20;
constexpr size_t WS_CTL = 0, CTL_ZERO_BYTES = 1 * MiB;
constexpr size_t WS_WSB = 1 * MiB;
constexpr size_t WS_PWT = 1 * MiB + 512 * 1024;
constexpr size_t WS_WIN = 2 * MiB;
constexpr size_t WS_WOUT = 18 * MiB;
constexpr size_t WS_Z = 292 * MiB;
constexpr size_t WS_YM = 123 * MiB;
constexpr size_t WS_VSTAT = 155 * MiB;
constexpr size_t WS_LIST = 400 * MiB;
constexpr size_t WS_TOKINFO = 165 * MiB;
constexpr size_t WS_RSTD = 165 * MiB + 512 * 1024;
constexpr size_t WS_HMOE = 166 * MiB;
constexpr size_t WS_YMOE = 208 * MiB;
constexpr size_t WS_XB = 420 * MiB;
constexpr size_t WS_X16 = 1092 * MiB;
constexpr size_t WS_WRT = 1124 * MiB;
constexpr size_t WS_END = 1126 * MiB;
constexpr int CW_TMO = 0, CW_BAR = 4096, CW_CNT = 8192  , CW_DBG = 40960, CW_BLK = 65536  ;

constexpr int RING_BYTES = 147456;
constexpr int MISC_OFF = RING_BYTES;
constexpr int LDS_BYTES = 161792;
constexpr int MO_BAR = 0;
constexpr int MO_CNT = 64;
constexpr int MO_SEG = MO_CNT + 256;
constexpr int MO_FST = MO_SEG + 272;
constexpr int MO_HST = MO_FST + 272;
constexpr int MAXU = 4;
constexpr int MO_TAB = MO_HST + 272;
constexpr int MO_NMY = MO_TAB + MAXU * 32;
constexpr int MO_TOKS = 2048;
constexpr int MO_GATES = 2048 + 4096;
static_assert(MO_NMY + 4 * MAXU <= MO_TOKS, "misc map");
constexpr int MO_RSTD = MO_GATES + 4096;
static_assert(MISC_OFF + MO_RSTD + MAXU * 1024 <= LDS_BYTES, "misc map 2");

__device__ __forceinline__ unsigned cvt_pk_bf16(float lo, float hi) { unsigned r; asm volatile("v_cvt_pk_bf16_f32 %0, %1, %2" : "=v"(r) : "v"(lo), "v"(hi)); return r; }
__device__ __forceinline__ float bf_lo(unsigned u) { return __builtin_bit_cast(float, u << 16); }
__device__ __forceinline__ float bf_hi(unsigned u) { return __builtin_bit_cast(float, u & 0xffff0000u); }
__device__ __forceinline__ float wave_sum(float v) {
#pragma unroll
    for (int o = 1; o < 64; o <<= 1) v += __shfl_xor(v, o);
    return v;
}
__device__ __forceinline__ float wave_max(float v) {
#pragma unroll
    for (int o = 1; o < 64; o <<= 1) v = fmaxf(v, __shfl_xor(v, o));
    return v;
}
__device__ __forceinline__ float gelu_tanh(float x) {
    const float u = 0.7978845608028654f * (x + 0.044715f * x * x * x);
    const float e = __builtin_amdgcn_exp2f(-2.0f * 1.4426950408889634f * u);
    return x * __builtin_amdgcn_rcpf(1.0f + e);
}
__device__ __forceinline__ float silu_f(float x) {
    const float e = __builtin_amdgcn_exp2f(-1.4426950408889634f * x);
    return x * __builtin_amdgcn_rcpf(1.0f + e);
}
__device__ __forceinline__ int opaque_tid() { int t = (int)threadIdx.x; asm volatile("" : "+v"(t)); return t; }
#define LDS_WAIT() asm volatile("s_waitcnt lgkmcnt(0)" ::: "memory")
#define VM_WAIT() asm volatile("s_waitcnt vmcnt(0)" ::: "memory")

#define XB_TMO      128
#define XB_XCNT(j)  (256  + 64 * (j))
#define XB_XSUB(j)  (1280 + 64 * (j))
#define XB_XGEN(j)  (2304 + 64 * (j))
#define XB_TOP      3328
#define XB_TOPGEN   3392
#define XCD_BAR_WORDS 3456
#define XB_SPIN_CAP (1u << 20)

__device__ __forceinline__ unsigned xb_ld(unsigned* p)              { return __hip_atomic_load(p, __ATOMIC_RELAXED, __HIP_MEMORY_SCOPE_AGENT); }
__device__ __forceinline__ unsigned xb_add(unsigned* p, unsigned v) { return __hip_atomic_fetch_add(p, v, __ATOMIC_RELAXED, __HIP_MEMORY_SCOPE_AGENT); }
__device__ __forceinline__ unsigned xb_xcc_id() { return (unsigned)__builtin_amdgcn_s_getreg((3 << 11) | 20) & 0xFu; }
#define XB_SPIN(cond, bar) do { unsigned _sp = 0; while (cond) { __builtin_amdgcn_s_sleep(1); \
    if ((++_sp & 255u) == 0u) { if (xb_ld(&(bar)[XB_TMO])) break; if (_sp > XB_SPIN_CAP) { atomicAdd(&(bar)[XB_TMO], 1u); break; } } } } while (0)

struct XcdBarrier { unsigned* bar; unsigned x; volatile LAS unsigned* st; };

__device__ __forceinline__ XcdBarrier xcd_barrier_post(unsigned* bar, volatile LAS unsigned* st) {
    XcdBarrier b; b.bar = bar; b.x = xb_xcc_id(); b.st = st;
    if (threadIdx.x == 0) (void)xb_add(&bar[XB_XCNT(b.x)], 1u);
    return b;
}
__device__ __forceinline__ void xcd_barrier_complete(unsigned* bar, unsigned x, unsigned& nloc, unsigned& nx) {
    const unsigned G = gridDim.x * gridDim.y * gridDim.z;
    unsigned sum, cnt, mine, sp = 0u;
    for (;;) {
        sum = 0u; cnt = 0u; mine = 0u;
#pragma unroll
        for (unsigned j = 0; j < 16; ++j) { const unsigned c = xb_ld(&bar[XB_XCNT(j)]); sum += c; cnt += (c > 0u) ? 1u : 0u; mine = (j == x) ? c : mine; }
        if (sum == G) break;
        __builtin_amdgcn_s_sleep(1);
        if ((++sp & 255u) == 0u) { if (xb_ld(&bar[XB_TMO])) break; if (sp > XB_SPIN_CAP) { atomicAdd(&bar[XB_TMO], 1u); break; } }
    }
    nloc = mine > 0u ? mine : 1u; nx = cnt > 0u ? cnt : 1u;
}
__device__ __forceinline__ void xcd_barrier(const XcdBarrier& b) {
    asm volatile("s_waitcnt vmcnt(0)" ::: "memory");
    __syncthreads();
    if (threadIdx.x == 0) {
        unsigned* bar = b.bar;
        __builtin_amdgcn_s_waitcnt(0);
        unsigned nloc = b.st[0], nx = b.st[1];
        if (nloc == 0u) { xcd_barrier_complete(bar, b.x, nloc, nx); b.st[0] = nloc; b.st[1] = nx; }
        const unsigned old = xb_add(&bar[XB_XSUB(b.x)], 1u);
        const unsigned gen = old / nloc;
        if (old + 1u == (gen + 1u) * nloc) {
            __builtin_amdgcn_fence(__ATOMIC_RELEASE, "agent");
            asm volatile("s_waitcnt vmcnt(0)" ::: "memory");
            const unsigned og = xb_add(&bar[XB_TOP], 1u);
            const unsigned tg = og / nx;
            if (og + 1u == (tg + 1u) * nx) xb_add(&bar[XB_TOPGEN], 1u);
            else XB_SPIN(xb_ld(&bar[XB_TOPGEN]) == tg, bar);
            __builtin_amdgcn_fence(__ATOMIC_ACQUIRE, "agent");
            xb_add(&bar[XB_XGEN(b.x)], 1u);
            asm volatile("s_waitcnt vmcnt(0)" ::: "memory");
        } else {
            XB_SPIN(xb_ld(&bar[XB_XGEN(b.x)]) == gen, bar);
            __builtin_amdgcn_fence(__ATOMIC_ACQUIRE, "agent");
            asm volatile("s_waitcnt vmcnt(0)" ::: "memory");
        }
    }
    __syncthreads();
}

namespace pg8 {
constexpr int BM = 256, BK = 64, HALF = 128, HTB = HALF * BK * 2, STAGE_BYTES = 8 * HTB, NXCD = 8, WGM = 8;
__host__ __device__ __forceinline__ int lds_byte(int r, int c) { const int st = (r >> 4) * 2 + (c >> 5), rr = r & 15, cc = c & 31, ob = rr * 64 + cc * 2; return st * 1024 + (ob ^ (((ob >> 9) & 1) << 5)); }
__host__ __device__ __forceinline__ void stage_rc(int b, int& R, int& C) { const int st = b / 1024, sb = b % 1024, swz = sb ^ (((sb >> 9) & 1) << 5); R = (st >> 1) * 16 + swz / 64; C = (st & 1) * 32 + (swz % 64) / 2; }
__host__ __device__ __forceinline__ int perm32(int rho) { const int n = rho >> 4, i = rho & 15; return 8 * (i >> 2) + 4 * n + (i & 3); }

struct Unit { const char* A; const char* B; int rowbase; int pn; int nvalid; int slot; };

struct PlainSched {
    static constexpr bool ALWAYS_FULL = true;
    const char* A; const char* Bt; int K; int nM, nN, nwg, G, c;
    __device__ __forceinline__ void init(const void* A_, const void* Bt_, int M, int N, int K_, int G_, int c_) { A = (const char*)A_; Bt = (const char*)Bt_; K = K_; nM = M / BM; nN = N / BM; nwg = nM * nN; G = G_; c = c_; }
    __device__ __forceinline__ bool next(int i, Unit& u) const {
        const long L = (long)i * G + c; if (L >= nwg) return false;
        int wgid = (int)L; { const int q = nwg / NXCD, r = nwg % NXCD, xcd = wgid % NXCD, off = wgid / NXCD; wgid = (xcd < r ? xcd * (q + 1) : r * (q + 1) + (xcd - r) * q) + off; }
        const int nig = WGM * nN, gid = wgid / nig, fm = gid * WGM, gsz = (nM - fm) < WGM ? (nM - fm) : WGM;
        const int pm = fm + ((wgid % nig) % gsz), pn = (wgid % nig) / gsz;
        u.A = A + (size_t)pm * BM * K * 2; u.B = Bt + (size_t)pn * BM * K * 2; u.rowbase = pm * BM; u.pn = pn; u.nvalid = 256; u.slot = 0; return true;
    }
    __device__ __forceinline__ void aoff(const Unit& u, const int (&R)[2], const int (&C)[2], unsigned (&vo)[2][2]) const {
#pragma unroll
        for (int h = 0; h < 2; ++h)
#pragma unroll
            for (int i = 0; i < 2; ++i) vo[h][i] = (unsigned)(((h * HALF + R[i]) * K + C[i]) * 2);
    }
};

template <class Epi, class Sched, bool ALIGN_EPI>
__device__ __forceinline__ void gemm_phase(LAS unsigned char* lds, const int K, const Sched& S, const Epi& E) {
    const int tid = opaque_tid(), wid = __builtin_amdgcn_readfirstlane(tid >> 6), lane = tid & 63, wr = wid >> 2, wc = wid & 3, fr = lane & 15, fq = lane >> 4;
    const int nt = K / BK;
    int Rr[2], Cc[2]; unsigned voffB[2];
#pragma unroll
    for (int i = 0; i < 2; ++i) { int R, C; stage_rc(tid * 16 + i * 8192, R, C); const int Rb = Epi::PERM ? ((R & ~31) + perm32(R & 31)) : R;
        Rr[i] = R; Cc[i] = C; voffB[i] = (unsigned)(Rb * K + C) * 2u; }
    const size_t kstep = (size_t)(BK * 2);
    const size_t hstepB = (size_t)HALF * K * 2;
    const unsigned ldsw = (unsigned)wid * 1024u;
    const int aoff = lds_byte(wr * 64 + fr, fq * 8), boff = lds_byte(wc * 32 + fr, fq * 8);
#define PG8_SA(b, h) (((b) * 2 + (h)) * HTB)
#define PG8_SB(b, h) ((4 + (b) * 2 + (h)) * HTB)
#define PG8_STAGE(bufoff, gbase, voff) do { _Pragma("unroll") for (int _i = 0; _i < 2; ++_i) \
        __builtin_amdgcn_global_load_lds((const unsigned*)((const char*)(gbase) + (voff)[_i]), (LAS unsigned*)(lds + (bufoff) + ldsw + _i * 8192), 16, 0, 0); } while (0)
#define PG8_LDA(dst, b, h) do { _Pragma("unroll") for (int m = 0; m < 4; ++m) _Pragma("unroll") for (int k = 0; k < 2; ++k) dst[m][k] = *(const LAS bf16x8*)(lds + PG8_SA(b, h) + aoff + m * 2048 + k * 1024); } while (0)
#define PG8_LDB(dst, b, h) do { _Pragma("unroll") for (int n = 0; n < 2; ++n) _Pragma("unroll") for (int k = 0; k < 2; ++k) dst[n][k] = *(const LAS bf16x8*)(lds + PG8_SB(b, h) + boff + n * 2048 + k * 1024); } while (0)
#define PG8_MMA(ai, bj, At, Bt) do { __builtin_amdgcn_s_setprio(1); _Pragma("unroll") for (int m = 0; m < 4; ++m) _Pragma("unroll") for (int n = 0; n < 2; ++n) _Pragma("unroll") for (int k = 0; k < 2; ++k) \
        acc[ai][bj][m][n] = __builtin_amdgcn_mfma_f32_16x16x32_bf16(Bt[n][k], At[m][k], acc[ai][bj][m][n], 0, 0, 0); __builtin_amdgcn_s_setprio(0); } while (0)
#define PG8_WAIT_V(n) asm volatile("s_waitcnt vmcnt(" #n ")" ::: "memory")
#define PG8_WAIT_L(n) asm volatile("s_waitcnt lgkmcnt(" #n ")" ::: "memory")
#define PG8_BAR __builtin_amdgcn_s_barrier()
#define PG8_SCHED __builtin_amdgcn_sched_barrier(0)
    Unit cur, nxt; int ui = 0;
    if (!S.next(0, cur)) return;
    f32x4 acc[2][2][4][2];
#pragma unroll
    for (int a = 0; a < 2; ++a)
#pragma unroll
        for (int b = 0; b < 2; ++b)
#pragma unroll
            for (int m = 0; m < 4; ++m)
#pragma unroll
                for (int n = 0; n < 2; ++n) acc[a][b][m][n] = (f32x4){0.f, 0.f, 0.f, 0.f};
    bf16x8 At[4][2], B0[2][2], B1[2][2];
    unsigned vo[2][2];
    S.aoff(cur, Rr, Cc, vo);
    {
        const char* cA = cur.A; const char* cB = cur.B;
        PG8_STAGE(PG8_SB(0, 0), cB, voffB); PG8_STAGE(PG8_SB(0, 1), cB + hstepB, voffB); PG8_STAGE(PG8_SA(0, 0), cA, vo[0]); PG8_STAGE(PG8_SA(0, 1), cA, vo[1]);
        if (wr == 1) PG8_BAR;
        PG8_WAIT_V(2); PG8_BAR;
        PG8_STAGE(PG8_SB(1, 0), cB + kstep, voffB); PG8_STAGE(PG8_SA(1, 0), cA + kstep, vo[0]); PG8_STAGE(PG8_SB(1, 1), cB + hstepB + kstep, voffB);
        PG8_WAIT_V(6); PG8_BAR;
    }
    for (;;) {
        const bool has_next = S.next(ui + 1, nxt);
        const char* cA = cur.A; const char* cB = cur.B;
        const char* nA = has_next ? nxt.A : cA; const char* nB = has_next ? nxt.B : cB;
        const bool full = Sched::ALWAYS_FULL ? true : (cur.nvalid > 128);
        for (int t = 0; t < nt; t += 2) {
            const bool last = (t == nt - 2);
            const char* a1 = cA + (size_t)(t + 1) * kstep;
            const char* a2 = last ? nA : cA + (size_t)(t + 2) * kstep; const char* b2 = last ? nB : cB + (size_t)(t + 2) * kstep;
            const char* a3 = a2 + kstep; const char* b3 = b2 + kstep;
            PG8_LDB(B0, 0, 0); PG8_LDB(B1, 0, 1); PG8_SCHED; PG8_LDA(At, 0, 0); PG8_STAGE(PG8_SA(1, 1), a1, vo[1]);
            if (last && has_next) S.aoff(nxt, Rr, Cc, vo);
            PG8_WAIT_V(8); PG8_WAIT_L(0); PG8_BAR; PG8_MMA(0, 0, At, B0); PG8_MMA(0, 1, At, B1); PG8_BAR; PG8_SCHED;
            PG8_LDA(At, 0, 1); PG8_STAGE(PG8_SB(0, 0), b2, voffB); PG8_STAGE(PG8_SB(0, 1), b2 + hstepB, voffB); PG8_STAGE(PG8_SA(0, 0), a2, vo[0]);
            PG8_WAIT_V(8); PG8_WAIT_L(0); PG8_BAR; if (full) { PG8_MMA(1, 0, At, B0); PG8_MMA(1, 1, At, B1); } PG8_BAR; PG8_SCHED;
            PG8_LDB(B0, 1, 0); PG8_LDB(B1, 1, 1); PG8_SCHED; PG8_LDA(At, 1, 0); PG8_STAGE(PG8_SA(0, 1), a2, vo[1]);
            PG8_WAIT_V(8); PG8_WAIT_L(0); PG8_BAR; PG8_MMA(0, 0, At, B0); PG8_MMA(0, 1, At, B1); PG8_BAR; PG8_SCHED;
            PG8_LDA(At, 1, 1); PG8_STAGE(PG8_SB(1, 0), b3, voffB); PG8_STAGE(PG8_SB(1, 1), b3 + hstepB, voffB); PG8_STAGE(PG8_SA(1, 0), a3, vo[0]);
            PG8_WAIT_V(8); PG8_WAIT_L(0); PG8_BAR; if (full) { PG8_MMA(1, 0, At, B0); PG8_MMA(1, 1, At, B1); } PG8_BAR; PG8_SCHED;
        }
        if constexpr (ALIGN_EPI) { if (wr == 0) PG8_BAR; }
        E(acc, cur, wr, wc, fr, fq);
        if (!has_next) break;
#pragma unroll
        for (int a = 0; a < 2; ++a)
#pragma unroll
            for (int b = 0; b < 2; ++b)
#pragma unroll
                for (int m = 0; m < 4; ++m)
#pragma unroll
                    for (int n = 0; n < 2; ++n) acc[a][b][m][n] = (f32x4){0.f, 0.f, 0.f, 0.f};
        cur = nxt; ++ui;
        if constexpr (ALIGN_EPI) { if (wr == 1) PG8_BAR; }
    }
    PG8_WAIT_V(0);
    if constexpr (!ALIGN_EPI) { if (wr == 0) PG8_BAR; }
    PG8_BAR;
#undef PG8_SA
#undef PG8_SB
#undef PG8_STAGE
#undef PG8_LDA
#undef PG8_LDB
#undef PG8_MMA
#undef PG8_WAIT_V
#undef PG8_WAIT_L
#undef PG8_BAR
#undef PG8_SCHED
}

template <bool ODD> struct EpiZ {
    static constexpr bool PERM = true;
    bf16_t* Z; float* vstat; const float* rstd;
    __device__ __forceinline__ void operator()(const f32x4 (&acc)[2][2][4][2], const Unit& u, int wr, int wc, int fr, int fq) const {
        const int row0 = u.rowbase + wr * 64 + fr; const int col0 = u.pn * BM + wc * 32 + 8 * fq;
        float rsv[2][4];
#pragma unroll
        for (int ai = 0; ai < 2; ++ai)
#pragma unroll
            for (int m = 0; m < 4; ++m) rsv[ai][m] = rstd[row0 + ai * HALF + m * 16];
#pragma unroll
        for (int ai = 0; ai < 2; ++ai)
#pragma unroll
            for (int m = 0; m < 4; ++m) {
                const int row = row0 + ai * HALF + m * 16;
                bf16_t* rowp = Z + (size_t)row * ZP + col0;
                float s = 0.f, q = 0.f;
#pragma unroll
                for (int bj = 0; bj < 2; ++bj) {
                    f32x4 v0 = acc[ai][bj][m][0] * rsv[ai][m], v1 = acc[ai][bj][m][1] * rsv[ai][m];
                    if (ODD) {
#pragma unroll
                        for (int j = 0; j < 4; ++j) { v0[j] = gelu_tanh(v0[j]); v1[j] = gelu_tanh(v1[j]); s += v0[j] + v1[j]; q += v0[j] * v0[j] + v1[j] * v1[j]; }
                    }
                    u32x4 w; w.x = cvt_pk_bf16(v0[0], v0[1]); w.y = cvt_pk_bf16(v0[2], v0[3]); w.z = cvt_pk_bf16(v1[0], v1[1]); w.w = cvt_pk_bf16(v1[2], v1[3]);
                    *(u32x4*)(rowp + bj * HALF) = w;
                }
                if (ODD) {
                    s += __shfl_xor(s, 16); s += __shfl_xor(s, 32); q += __shfl_xor(q, 16); q += __shfl_xor(q, 32);
                    if (u.pn >= 4 && fq == 0) *(f32x2*)(vstat + ((size_t)row * 16 + (u.pn - 4) * 4 + wc) * 2) = (f32x2){s, q};
                }
            }
    }
};
struct EpiResid {
    static constexpr bool PERM = true;
    const bf16_t* __restrict__ Xin; bf16_t* __restrict__ Xout;
    __device__ __forceinline__ void operator()(const f32x4 (&acc)[2][2][4][2], const Unit& u, int wr, int wc, int fr, int fq) const {
        const int row0 = u.rowbase + wr * 64 + fr, col0 = u.pn * BM + wc * 32 + 8 * fq;
#pragma unroll
        for (int ai = 0; ai < 2; ++ai) {
            u32x4 t[4][2];
#pragma unroll
            for (int m = 0; m < 4; ++m) { const bf16_t* rowp = Xin + (size_t)(row0 + ai * HALF + m * 16) * DM + col0;
#pragma unroll
                for (int bj = 0; bj < 2; ++bj) t[m][bj] = *(const u32x4*)(rowp + bj * HALF); }
#pragma unroll
            for (int m = 0; m < 4; ++m) { bf16_t* rowp = Xout + (size_t)(row0 + ai * HALF + m * 16) * DM + col0;
#pragma unroll
                for (int bj = 0; bj < 2; ++bj) { const f32x4 v0 = acc[ai][bj][m][0], v1 = acc[ai][bj][m][1]; const u32x4 x = t[m][bj]; u32x4 w;
                    w.x = cvt_pk_bf16(bf_lo(x.x) + v0[0], bf_hi(x.x) + v0[1]); w.y = cvt_pk_bf16(bf_lo(x.y) + v0[2], bf_hi(x.y) + v0[3]);
                    w.z = cvt_pk_bf16(bf_lo(x.z) + v1[0], bf_hi(x.z) + v1[1]); w.w = cvt_pk_bf16(bf_lo(x.w) + v1[2], bf_hi(x.w) + v1[3]);
                    *(u32x4*)(rowp + bj * HALF) = w; } }
        }
    }
};
}

struct Args { const float* in[20]; float* out; unsigned char* ws; int ph_lo, ph_hi; };
static_assert(sizeof(Args) == 184, "Args layout");
struct Frame {
    LAS unsigned char* lds;
};
#define F_TID (opaque_tid())
#define F_LANE (opaque_tid() & 63)
#define F_WAVE (__builtin_amdgcn_readfirstlane(opaque_tid() >> 6))
#define F_G ((int)gridDim.x)
#define F_BID ((int)blockIdx.x)
#define CAS __attribute__((address_space(4)))
__device__ __forceinline__ const CAS char* karg_base() { const CAS char* p = (const CAS char*)__builtin_amdgcn_kernarg_segment_ptr(); asm volatile("" : "+s"(p)); return p; }
#define KIN(k) ((const float*)(*(const GAS float* const CAS*)(karg_base() + 8 * (k))))
#define F_WS ((unsigned char*)(*(GAS unsigned char* const CAS*)(karg_base() + 168)))
#define F_X ((float*)(*(GAS float* const CAS*)(karg_base() + 160)))
#define F_CTL ((unsigned*)(F_WS + WS_CTL))

namespace pg4 {
constexpr int BPL = 4352;
struct Unit4 { int rowbase; int pn; int nvalid; int slot; };
__device__ __forceinline__ int off32(int r, int c) { const int ob = (r & 15) * 64 + c * 2; return (r >> 4) * 1024 + (ob ^ (((ob >> 9) & 1) << 5)); }
__device__ __forceinline__ void stage_rc32(int b, int& R, int& C) { const int st = b >> 10, sb = b & 1023, swz = sb ^ (((sb >> 9) & 1) << 5); R = st * 16 + (swz >> 6); C = (swz & 63) >> 1; }

__device__ __forceinline__ void epi_gu4(bf16_t* H, const LAS float* rstd, const f32x4 (&acc)[8][4], const Unit4& u, int wr, int wc, int fr, int fq) {
    asm volatile("" : "+v"(fr), "+v"(fq));
    const int col0 = u.pn * 128 + wc * 32 + 8 * fq;
    const __amdgpu_buffer_rsrc_t hrs = __builtin_amdgcn_make_buffer_rsrc(H, 0, NR_ALLOC * DE * 2, 0x00020000);
#pragma unroll
    for (int m = 0; m < 8; ++m) {
        const int lr = wr * 128 + m * 16 + fr;
        if (lr < u.nvalid) {
            const float rr = rstd[u.slot * 256 + lr];
            const f32x4 g0 = acc[m][0] * rr, g1 = acc[m][1] * rr, u0 = acc[m][2] * rr, u1 = acc[m][3] * rr; u32x4 w;
            w.x = cvt_pk_bf16(silu_f(g0[0]) * u0[0], silu_f(g0[1]) * u0[1]); w.y = cvt_pk_bf16(silu_f(g0[2]) * u0[2], silu_f(g0[3]) * u0[3]);
            w.z = cvt_pk_bf16(silu_f(g1[0]) * u1[0], silu_f(g1[1]) * u1[1]); w.w = cvt_pk_bf16(silu_f(g1[2]) * u1[2], silu_f(g1[3]) * u1[3]);
            __builtin_amdgcn_raw_buffer_store_b128(w, hrs, (unsigned)(((u.rowbase + lr) * DE + col0) * 2), 0,   16);
        }
    }
}
__device__ __forceinline__ void epi_down4(bf16_t* Y, const LAS float* gates, const f32x4 (&acc)[8][4], const Unit4& u, int wr, int wc, int fr, int fq) {
    asm volatile("" : "+v"(fr), "+v"(fq));
    const int col0 = u.pn * 256 + wc * 64 + 16 * fq;
#pragma unroll
    for (int m = 0; m < 8; ++m) {
        const int lr = wr * 128 + m * 16 + fr;
        if (lr < u.nvalid) {
            const float g = gates[u.slot * 256 + lr];
#pragma unroll
            for (int n2 = 0; n2 < 2; ++n2) { const f32x4 v0 = acc[m][2 * n2] * g, v1 = acc[m][2 * n2 + 1] * g; u32x4 w;
                w.x = cvt_pk_bf16(v0[0], v0[1]); w.y = cvt_pk_bf16(v0[2], v0[3]); w.z = cvt_pk_bf16(v1[0], v1[1]); w.w = cvt_pk_bf16(v1[2], v1[3]);
                *(u32x4*)(Y + (size_t)(u.rowbase + lr) * DM + col0 + 8 * n2) = w; }
        }
    }
}
template <int MODE  , int NT  , int LDB>
__device__ __forceinline__ void gemm4_phase(LAS unsigned char* lds, const LAS int* tab, const LAS unsigned short* toks, const LAS float* gates  , const char* Abase, const float* W0, const float* W1, const float* Gk, bf16_t* Out, const int layer, const int nunits) {
    const int tid = opaque_tid(), wid = __builtin_amdgcn_readfirstlane(tid >> 6), lane = tid & 63, wr = wid >> 2, wc = wid & 3, fr = lane & 15, fq = lane >> 4;
    if (nunits <= 0) return;
    constexpr int ABLK = 32768, BOFF = 3 * ABLK, BSTG = 4 * BPL;
    const unsigned ldsw = (unsigned)wid * 1024u;
    const int aoff = wr * 16384 + pg8::lds_byte(fr, fq * 8);
    const int boff = BOFF + fq * BPL + ((fr & 3) * 68 + ((wc * 64 + fr) >> 2)) * 16;
    const int kg = wid, ng = lane;
    const unsigned bw0 = (unsigned)(BOFF + (kg >> 1) * BPL + ng * 16 + 8 * (kg & 1));
    const int bsel = MODE == 0 ? ((ng >> 3) & 1) : 0;
    const int bcolv = MODE == 0 ? (32 * (ng >> 4) + 8 * (ng & 3) + 4 * ((ng >> 2) & 1)) : (64 * (ng >> 4) + 16 * (ng & 3) + 4 * ((ng >> 2) & 3));
    const unsigned bthr = (unsigned)((4 * kg * LDB + bcolv) * 4);
    const int TT = nunits * NT;
    Unit4 uc; int sa = 0, sb = 0, sc2 = 0, ka = 0, kb = 0, kc = 0;
#define G4_NEXTC(i) do { uc.rowbase = __builtin_amdgcn_readfirstlane(tab[(i) * 8 + 3]); uc.nvalid = __builtin_amdgcn_readfirstlane(tab[(i) * 8 + 4]); uc.pn = __builtin_amdgcn_readfirstlane(tab[(i) * 8 + 2]); uc.slot = (i); } while (0)
#define G4_NEXTA(i) do { if (MODE == 0) curA = Abase; else curA = Abase + (size_t)__builtin_amdgcn_readfirstlane(tab[(i) * 8 + 3]) * DE * 2; \
        _Pragma("unroll") for (int _h = 0; _h < 2; ++_h) _Pragma("unroll") for (int _i = 0; _i < 2; ++_i) { int _R, _C; pg8::stage_rc(tid * 16 + _i * 8192, _R, _C); \
            vo[_h][_i] = MODE == 0 ? (unsigned)(((int)toks[(i) * 256 + _h * 128 + _R] * DM + _C) * 2) : (unsigned)(((_h * 128 + _R) * DE + _C) * 2); } } while (0)
#define G4_NEXTB(i) do { const int _e = __builtin_amdgcn_readfirstlane(tab[(i) * 8 + 0]), _ct = __builtin_amdgcn_readfirstlane(tab[(i) * 8 + 2]); \
        if (MODE == 0) { const size_t _wo = (size_t)(layer * NE + _e) * DM * DE + (size_t)_ct * 128; curB0 = W0 + _wo; curB1 = W1 + _wo; } \
        else { curB0 = W0 + (size_t)(layer * NE + _e) * DE * DM + (size_t)_ct * 256; curB1 = curB0; } } while (0)
    const char* curA; const float* curB0; const float* curB1; unsigned vo[2][2];
    G4_NEXTC(0); G4_NEXTA(0); G4_NEXTB(0);
    f32x4 acc[8][4];
#pragma unroll
    for (int m = 0; m < 8; ++m)
#pragma unroll
        for (int n = 0; n < 4; ++n) acc[m][n] = (f32x4){0.f, 0.f, 0.f, 0.f};
    f32x4 Br[3][4];
#define G4_ISSUE_A(blk) do { const char* _ap = curA + (size_t)ka * 128; \
        _Pragma("unroll") for (int _h = 0; _h < 2; ++_h) _Pragma("unroll") for (int _i = 0; _i < 2; ++_i) \
            __builtin_amdgcn_global_load_lds((const unsigned*)(_ap + vo[_h][_i]), (LAS unsigned*)(lds + (blk) * ABLK + _h * 16384 + ldsw + _i * 8192), 16, 0, 0); \
        if (++ka == NT / 2) { ka = 0; if (sa + 1 < nunits) { ++sa; G4_NEXTA(sa); } } } while (0)
#define G4_ISSUE_B(rs) do { const char* _bp = (const char*)(bsel ? curB1 : curB0) + (size_t)kb * (32 * LDB * 4) + bthr; \
        _Pragma("unroll") for (int _j = 0; _j < 4; ++_j) { const char* _p = _bp + (size_t)_j * (LDB * 4); \
            asm volatile("global_load_dwordx4 %0, %1, off ; G4_BLOAD" : "=&v"(Br[rs][_j]) : "v"(_p) : "memory"); } \
        if (++kb == NT) { kb = 0; if (sb + 1 < nunits) { ++sb; G4_NEXTB(sb); } } } while (0)
    f32x4 gq[2] = {(f32x4){1.f, 1.f, 1.f, 1.f}, (f32x4){1.f, 1.f, 1.f, 1.f}};
#define G4_LOAD_G(q, kstep) do { if (MODE == 0) { const float* _gp = Gk + (((kstep) & (NT - 1)) * 32 + 4 * kg); asm volatile("s_load_dwordx4 %0, %1, 0x0" : "=s"(gq[q]) : "s"(_gp) : "memory"); } } while (0)
#define G4_FENCE_G() do { if (MODE == 0) asm volatile("" : "+s"(gq[0]), "+s"(gq[1])); } while (0)
#define G4_WRITE_B(rs, bst, q) do { _Pragma("unroll") for (int _i = 0; _i < 4; ++_i) { u32x2 _w; \
        if (MODE == 0) { _w.x = cvt_pk_bf16(Br[rs][0][_i] * gq[q][0], Br[rs][1][_i] * gq[q][1]); _w.y = cvt_pk_bf16(Br[rs][2][_i] * gq[q][2], Br[rs][3][_i] * gq[q][3]); } \
        else { _w.x = cvt_pk_bf16(Br[rs][0][_i], Br[rs][1][_i]); _w.y = cvt_pk_bf16(Br[rs][2][_i], Br[rs][3][_i]); } \
        *(LAS u32x2*)(lds + (bst) * BSTG + bw0 + 1088 * _i) = _w; } } while (0)
#define G4_WAIT_V(n) asm volatile("s_waitcnt vmcnt(" #n ")" ::: "memory")
#define G4_WAIT_L(n) asm volatile("s_waitcnt lgkmcnt(" #n ")" ::: "memory")
    G4_LOAD_G(0, 0); G4_LOAD_G(1, 1);
    G4_ISSUE_B(0); G4_ISSUE_A(0); G4_ISSUE_A(1); G4_ISSUE_B(1); G4_ISSUE_B(2); G4_WAIT_V(16); G4_WAIT_L(0); G4_FENCE_G(); G4_WRITE_B(0, 0, 0);
    G4_WAIT_V(12);
    int pendT = 0, pendB = 0; bool act0 = (wr < 1) || uc.nvalid > 128;
    int T = 0;
    bf16x8 Bf[4], Af[4];
#pragma unroll
    for (int i = 0; i < 4; ++i) { Bf[i] = (bf16x8){0, 0, 0, 0, 0, 0, 0, 0}; Af[i] = (bf16x8){0, 0, 0, 0, 0, 0, 0, 0}; }
#define G4_WAIT_TOP() do { if (pendT) { if (MODE == 0) G4_WAIT_V(28); else G4_WAIT_V(36); --pendT; } else G4_WAIT_V(20); } while (0)
#define G4_WAIT_B() do { if (pendB) { if (MODE == 0) G4_WAIT_V(16); else G4_WAIT_V(24); --pendB; } else G4_WAIT_V(8); } while (0)
#define G4_STEP(ab, p, rs) do { \
        if ((p) == 0) { G4_WAIT_TOP(); } \
        G4_WAIT_L(0); G4_FENCE_G(); __builtin_amdgcn_s_barrier(); \
        if ((p) == 0) { G4_ISSUE_A(((ab) + 2) % 3); } \
        if (act0) { \
            _Pragma("unroll") for (int n = 0; n < 4; ++n) Bf[n] = *(const LAS bf16x8*)(lds + (p) * BSTG + boff + n * 64); \
            _Pragma("unroll") for (int m = 0; m < 4; ++m) Af[m] = *(const LAS bf16x8*)(lds + (ab) * ABLK + aoff + m * 2048 + (p) * 1024); } \
        G4_WAIT_B(); asm volatile("; G4_BWAIT" ::: "memory"); \
        G4_WRITE_B(((rs) + 1) % 3, 1 - (p), 1 - (p)); G4_LOAD_G(p, T + 2); \
        G4_ISSUE_B(rs); \
        if (act0) { __builtin_amdgcn_s_setprio(1); \
            _Pragma("unroll") for (int m = 0; m < 4; ++m) _Pragma("unroll") for (int n = 0; n < 4; ++n) acc[m][n] = __builtin_amdgcn_mfma_f32_16x16x32_bf16(Bf[n], Af[m], acc[m][n], 0, 0, 0); \
            __builtin_amdgcn_s_setprio(0); \
            _Pragma("unroll") for (int m = 0; m < 4; ++m) Af[m] = *(const LAS bf16x8*)(lds + (ab) * ABLK + aoff + (m + 4) * 2048 + (p) * 1024); \
            __builtin_amdgcn_s_setprio(1); \
            _Pragma("unroll") for (int m = 0; m < 4; ++m) _Pragma("unroll") for (int n = 0; n < 4; ++n) acc[m + 4][n] = __builtin_amdgcn_mfma_f32_16x16x32_bf16(Bf[n], Af[m], acc[m + 4][n], 0, 0, 0); \
            __builtin_amdgcn_s_setprio(0); } \
        if (++kc == NT) { kc = 0; \
            if (MODE == 0) epi_gu4(Out, gates, acc, uc, wr, wc, fr, fq); else epi_down4(Out, gates, acc, uc, wr, wc, fr, fq); \
            if (wr < 1 || uc.nvalid > 128) { pendT = 2; pendB = 2; } else { pendT = 0; pendB = 0; } \
            _Pragma("unroll") for (int m = 0; m < 8; ++m) _Pragma("unroll") for (int n = 0; n < 4; ++n) acc[m][n] = (f32x4){0.f, 0.f, 0.f, 0.f}; \
            if (sc2 + 1 < nunits) { ++sc2; G4_NEXTC(sc2); act0 = (wr < 1) || uc.nvalid > 128; } } \
        ++T; } while (0)
    while (T + 6 <= TT) { G4_STEP(0, 0, 0); G4_STEP(0, 1, 1); G4_STEP(1, 0, 2); G4_STEP(1, 1, 0); G4_STEP(2, 0, 1); G4_STEP(2, 1, 2); }
    if (T + 2 <= TT) { G4_STEP(0, 0, 0); G4_STEP(0, 1, 1);
        if (T + 2 <= TT) { G4_STEP(1, 0, 2); G4_STEP(1, 1, 0); } }
    G4_WAIT_V(0); G4_WAIT_L(0); __builtin_amdgcn_s_barrier();
#pragma unroll
    for (int rs = 0; rs < 3; ++rs)
#pragma unroll
        for (int j = 0; j < 4; ++j) asm volatile("" :: "v"(Br[rs][j]));
#undef G4_NEXTA
#undef G4_NEXTB
#undef G4_NEXTC
#undef G4_ISSUE_A
#undef G4_ISSUE_B
#undef G4_WRITE_B
#undef G4_LOAD_G
#undef G4_FENCE_G
#undef G4_WAIT_V
#undef G4_WAIT_L
#undef G4_WAIT_TOP
#undef G4_WAIT_B
#undef G4_STEP
}
}

struct MoeTabs { LAS int* cnt; LAS int* seg; LAS int* fst; LAS int* hst; LAS int* tab; LAS int* nmy; LAS unsigned short* toks; LAS float* gates; LAS float* rstd; };
__device__ __forceinline__ MoeTabs moe_tabs(Frame& F) {
    MoeTabs T; LAS unsigned char* m = F.lds + MISC_OFF;
    T.cnt = (LAS int*)(m + MO_CNT); T.seg = (LAS int*)(m + MO_SEG); T.fst = (LAS int*)(m + MO_FST); T.hst = (LAS int*)(m + MO_HST); T.tab = (LAS int*)(m + MO_TAB); T.nmy = (LAS int*)(m + MO_NMY);
    T.toks = (LAS unsigned short*)(m + MO_TOKS); T.gates = (LAS float*)(m + MO_GATES); T.rstd = (LAS float*)(m + MO_RSTD); return T;
}
__device__ __forceinline__ void moe_build_seg(Frame& F, const Args& AR, const MoeTabs& T, int layer) {
    __syncthreads();
    if (F_TID < NE) T.cnt[F_TID] = (int)__hip_atomic_load(F_CTL + CW_CNT + (layer * NE + F_TID) * 64, __ATOMIC_RELAXED, __HIP_MEMORY_SCOPE_AGENT);
    __syncthreads();
    if (F_TID < NE) {
        const int e = F_TID, c = T.cnt[e], nb = (c + 127) >> 7;
        int s = nb * 128, fs = (nb >> 1) * 4, hs = (nb & 1) * 4;
        const int s0 = s, f0 = fs, h0 = hs;
#pragma unroll
        for (int o = 1; o < 64; o <<= 1) { const int a = __shfl_up(s, o), b = __shfl_up(fs, o), d = __shfl_up(hs, o); if (e >= o) { s += a; fs += b; hs += d; } }
        T.seg[e] = s - s0; T.fst[e] = fs - f0; T.hst[e] = hs - h0;
        if (e == NE - 1) { T.seg[NE] = s; T.fst[NE] = fs; T.hst[NE] = hs; }
    }
    __syncthreads();
}
__device__ __forceinline__ int moe_build_units(Frame& F, const Args& AR, const MoeTabs& T, int layer, int base, bool build, const int nfull, const int total, const bool deal2, int& nfw, const int sl0 = 0  ) {
    const int vcu = (F_G % 8 == 0) ? (F_BID % 8) * (F_G / 8) + F_BID / 8 : F_BID;
    int n = (total - base - vcu + F_G - 1) / F_G; n = n < 0 ? 0 : (n > MAXU ? MAXU : n);
    const int rv = F_G - 1 - vcu;
    nfw = (nfull - vcu + F_G - 1) / F_G; nfw = nfw < 0 ? 0 : (nfw > MAXU ? MAXU : nfw);
    if (deal2) { int nhw = (total - nfull - rv + F_G - 1) / F_G; nhw = nhw < 0 ? 0 : nhw; n = nfw + nhw; n = n > MAXU ? MAXU : n; }
    if (!build) return n;
    if (F_TID < 64) {
        const int e = F_TID; const int fa = T.fst[e], fb = T.fst[e + 1], ha = T.hst[e], hb = T.hst[e + 1];
#pragma unroll
        for (int i = 0; i < MAXU; ++i) {
            if (i >= sl0 && i < n) {
                const int L = deal2 ? (i < nfw ? i * F_G + vcu : nfull + (i - nfw) * F_G + rv) : base + i * F_G + vcu;
                const bool isf = L < nfull; const int Lr = isf ? L : L - nfull;
                const bool mine = isf ? (fa <= Lr && Lr < fb) : (ha <= Lr && Lr < hb);
                const unsigned long long mk = __ballot(mine);
                const int ee = (int)__builtin_ctzll(mk);
                if (e == ee) { const int r = Lr - (isf ? fa : ha), c = T.cnt[e]; const int nb = (c + 127) >> 7;
                    const int rb = isf ? (r >> 2) : (nb >> 1), ct = r & 3;
                    LAS int* t = T.tab + i * 8; t[0] = e; t[1] = rb; t[2] = ct; t[3] = T.seg[e] + rb * 256; t[4] = isf ? 256 : 128; t[5] = c - rb * 256; }
            }
        }
    }
    __syncthreads();
    const i32x4* list = (const i32x4*)(F_WS + WS_LIST);
    {
        const int tid = F_TID, row = tid & 255, sh = tid >> 8;
        i32x4 v[MAXU / 2];
#pragma unroll
        for (int p = 0; p < MAXU / 2; ++p) { const int sl = 2 * p + sh; v[p] = (i32x4){ZERO_ROW, 0, 0, 0};
            if (sl >= sl0 && sl < n) { const int e = T.tab[sl * 8 + 0], rb = T.tab[sl * 8 + 1], cl = T.tab[sl * 8 + 5];
                if (row < cl) v[p] = list[(size_t)e * NT + rb * 256 + row]; } }
#pragma unroll
        for (int p = 0; p < MAXU / 2; ++p) { const int sl = 2 * p + sh;
            if (sl >= sl0 && sl < n) { const int vx = v[p].x, vy = v[p].y, vz = v[p].z; T.toks[sl * 256 + row] = (unsigned short)vx; T.gates[sl * 256 + row] = __int_as_float(vy); T.rstd[sl * 256 + row] = __int_as_float(vz); } }
    }
    __syncthreads();
    return n;
}
constexpr int BLK_CTRS = 384;
__device__ __forceinline__ bool moe_fusable(int nfull, int total, int G) { return total <= MAXU * G && ((nfull + G - 1) / G + (total - nfull + G - 1) / G) <= MAXU; }
__device__ __forceinline__ void moe_publish(Frame& F, const Args& AR, const MoeTabs& T, int layer, int n) {
    if (F_TID < 64) {
        if (F_TID < n) { unsigned* c = F_CTL + CW_BLK + ((size_t)layer * BLK_CTRS + (T.tab[F_TID * 8 + 3] >> 7)) * 16; (void)xb_add(c, 1u); }
    }
}
__device__ __forceinline__ void moe_wait(Frame& F, const Args& AR, const MoeTabs& T, int layer, int s0, int s1) {
    if (F_TID < 64) {
        const int i = s0 + F_TID;
        if (i < s1) { unsigned* c = F_CTL + CW_BLK + ((size_t)layer * BLK_CTRS + (T.tab[i * 8 + 3] >> 7)) * 16; unsigned* bar = F_CTL + CW_BAR;
            XB_SPIN(xb_ld(c) < 4u, bar); }
        if (F_TID == 0) __builtin_amdgcn_fence(__ATOMIC_ACQUIRE, "agent");
    }
    asm volatile("s_waitcnt vmcnt(0)" ::: "memory");
    __syncthreads();
}
__device__ __forceinline__ unsigned f2bf(float f) { unsigned u = __builtin_bit_cast(unsigned, f); return (u + 0x7fffu + ((u >> 16) & 1u)) >> 16; }
__device__ __forceinline__ unsigned pk2(float lo, float hi) { return f2bf(lo) | (f2bf(hi) << 16); }
__device__ __forceinline__ void p0_transpose_item(const float* W, int N, bf16_t* WT, int Kd, int k0, int n0, int drow0, LAS float* scr, int lane, const float* gk) {
#pragma unroll 8
    for (int i = 0; i < 32; ++i) { const int kk = 2 * i + (lane >> 5); scr[kk * 33 + (lane & 31)] = W[(size_t)(k0 + kk) * N + n0 + (lane & 31)]; }
    LDS_WAIT(); asm volatile("" ::: "memory");
    const int c = lane & 7;
    f32x4 g0 = (f32x4){1.f, 1.f, 1.f, 1.f}, g1 = g0;
    if (gk) { g0 = *(const f32x4*)(gk + k0 + 8 * c); g1 = *(const f32x4*)(gk + k0 + 8 * c + 4); }
#pragma unroll
    for (int j = 0; j < 4; ++j) { const int n = (lane >> 3) + 8 * j; const LAS float* s = scr + (8 * c) * 33 + n;
        u32x4 o; o.x = pk2(s[0 * 33] * g0.x, s[1 * 33] * g0.y); o.y = pk2(s[2 * 33] * g0.z, s[3 * 33] * g0.w); o.z = pk2(s[4 * 33] * g1.x, s[5 * 33] * g1.y); o.w = pk2(s[6 * 33] * g1.z, s[7 * 33] * g1.w);
        *(u32x4*)(WT + (size_t)(drow0 + n) * Kd + k0 + 8 * c) = o; }
    LDS_WAIT(); asm volatile("" ::: "memory");
}
__device__ __forceinline__ void row_rstd(const f32x4 (&v)[4], int lane, float* out) {
    float s = 0.f;
#pragma unroll
    for (int j = 0; j < 4; ++j) s += (v[j].x * v[j].x + v[j].y * v[j].y) + (v[j].z * v[j].z + v[j].w * v[j].w);
    const float rstd = 1.0f / sqrtf(wave_sum(s) * (1.f / DM) + EPS);
    if (lane == 0) *out = rstd;
}
__device__ __forceinline__ void norm_row(const f32x4 (&v)[4], const float* g, int lane, bf16_t* ob, float* of, float oscale = 1.0f) {
    float s = 0.f;
#pragma unroll
    for (int j = 0; j < 4; ++j) s += (v[j].x * v[j].x + v[j].y * v[j].y) + (v[j].z * v[j].z + v[j].w * v[j].w);
    const float rstd = oscale / sqrtf(wave_sum(s) * (1.f / DM) + EPS);
#pragma unroll
    for (int j = 0; j < 4; ++j) {
        const f32x4 gg = *((const f32x4*)g + lane + 64 * j);
        const f32x4 y = v[j] * rstd * gg;
        if (ob) { u32x2 w; w.x = cvt_pk_bf16(y.x, y.y); w.y = cvt_pk_bf16(y.z, y.w); *((u32x2*)ob + lane + 64 * j) = w; }
        if (of) *((f32x4*)of + lane + 64 * j) = y;
    }
}
__device__ __forceinline__ void p0_prologue(Frame& F, const Args& AR) {
    LAS float* scr = (LAS float*)(F.lds + F_WAVE * 16384);
    const int gw = F_BID * NWAVES + F_WAVE, NGW = F_G * NWAVES;
    bf16_t* WIN = (bf16_t*)(F_WS + WS_WIN); bf16_t* WOUT = (bf16_t*)(F_WS + WS_WOUT);
    constexpr int I_IN = 16 * 64, I_OUT = 16 * 32, I_MIX = NL * (I_IN + I_OUT);
    for (int it = gw; it < I_MIX; it += NGW) {
        if (it < NL * I_IN) { const int l = it / I_IN, r = it % I_IN, kb = r / 64, nb = r % 64;
            const float* W = ((l & 1) ? KIN(8) : KIN(4)) + (size_t)(l >> 1) * DM * 2048;
            p0_transpose_item(W, 2048, WIN + (size_t)l * 2048 * DM, DM, kb * 64, nb * 32, nb * 32, scr, F_LANE, KIN(1) + (size_t)l * DM); continue; }
        const int q = it - NL * I_IN, l = q / I_OUT, r = q % I_OUT, kb = r / 32, nb = r % 32;
        const float* W = ((l & 1) ? KIN(12) : KIN(5)) + (size_t)(l >> 1) * DM * DM;
        p0_transpose_item(W, DM, WOUT + (size_t)l * DM * DM, DM, kb * 64, nb * 32, nb * 32, scr, F_LANE, nullptr);
    }
    {
        bf16_t* WSB = (bf16_t*)(F_WS + WS_WSB); bf16_t* PWT = (bf16_t*)(F_WS + WS_PWT);
        const int gt = F_BID * NTHR + F_TID, NGT = F_G * NTHR;
        for (int i = gt; i < 2 * 8 * 128 * 128; i += NGT) { const int jj = i & 127, ii = (i >> 7) & 127; const float v = (jj <= ii) ? KIN(10)[i] : 0.f; WSB[i] = (bf16_t)f2bf(v); }
        bf16_t* WRH = (bf16_t*)(F_WS + WS_WRT); bf16_t* WRL = WRH + NL * 80 * 1024;
        for (int i = gt; i < NL * 80 * 1024; i += NGT) { const int k = i & 1023, n = (i >> 10) % 80, l = i / 81920;
            const float w = (n < 8 ? KIN(13)[((size_t)l * 1024 + k) * 8 + n] : (n < 72 ? KIN(15)[((size_t)l * 1024 + k) * 64 + n - 8] : 0.f)) * KIN(2)[l * 1024 + k];
            const unsigned hi = f2bf(w); const float rem = w - bf_lo(hi);
            WRH[i] = (bf16_t)hi; WRL[i] = (bf16_t)f2bf(rem); }
        for (int i = gt; i < 2 * 4 * 128 * 128; i += NGT) { const int c = i & 127, d = (i >> 7) & 127, lg2 = i >> 14; PWT[i] = (bf16_t)f2bf(KIN(6)[(size_t)lg2 * 16384 + c * 128 + d]); }
    }
    bf16_t* XBz = (bf16_t*)(F_WS + WS_XB);
    for (int m0 = gw; m0 < NT; m0 += 4 * NGW) {
        f32x4 v[4][4];
#pragma unroll
        for (int q = 0; q < 4; ++q) { const int m = (m0 + q * NGW < NT) ? m0 + q * NGW : m0; const f32x4* xr = (const f32x4*)(KIN(0) + (size_t)m * DM) + F_LANE;
#pragma unroll
            for (int j = 0; j < 4; ++j) v[q][j] = xr[64 * j]; }
#pragma unroll
        for (int q = 0; q < 4; ++q) { const int m = m0 + q * NGW; if (m >= NT) break;
#pragma unroll
            for (int j = 0; j < 4; ++j) { u32x2 w; w.x = cvt_pk_bf16(v[q][j].x, v[q][j].y); w.y = cvt_pk_bf16(v[q][j].z, v[q][j].w); *((u32x2*)((bf16_t*)(F_WS + WS_X16) + (size_t)m * DM) + F_LANE + 64 * j) = w; }
            row_rstd(v[q], F_LANE, (float*)(F_WS + WS_RSTD) + m); }
    }
    if (gw == 0) { for (int j = 0; j < 4; ++j) *((u32x2*)(XBz + (size_t)ZERO_ROW * DM) + F_LANE + 64 * j) = (u32x2){0u, 0u}; }
}

typedef float f32x16 __attribute__((ext_vector_type(16)));
typedef short s16x4 __attribute__((ext_vector_type(4)));
constexpr int ATT_RS = 144;
constexpr int ATT_VBUF = 32 * ATT_RS;
__device__ __forceinline__ void attn_mfma(Frame& F, const Args& AR) {
    const bf16_t* Z = (const bf16_t*)(F_WS + WS_Z); bf16_t* YM = (bf16_t*)(F_WS + WS_YM);
    const int lane = F_LANE, l31 = lane & 31, hh = lane >> 5;
    LAS unsigned char* vbuf = F.lds + F_WAVE * (2 * ATT_VBUF);
    const int gi = (lane >> 4) & 1, q4 = (lane & 15) >> 2, p4 = lane & 3;
    const unsigned troff = (unsigned)((4 * hh + q4) * ATT_RS + (16 * gi + 4 * p4) * 2);
    const int vr8 = lane >> 3, vcol = lane & 7;
    const float SC = 0.125f * 1.4426950408889634f;
    const int NJOB = 2048, W0 = F_BID * NWAVES + F_WAVE, NW = F_G * NWAVES;
    for (int job = W0; job < NJOB; job += NW) {
        const int bh = job >> 5, b = bh >> 3, head = bh & 7, gp = (job >> 2) & 7, r = job & 3;
        for (int half = 0; half < 2; ++half) {
            const int g = half ? 15 - gp : gp;
            const int tq = b * SEQ + 128 * g + 4 * l31 + r;
            bf16x8 Qf[4];
#pragma unroll
            for (int s2 = 0; s2 < 4; ++s2) Qf[s2] = *(const bf16x8*)(Z + (size_t)tq * ZP + 512 + head * 64 + 16 * s2 + 8 * hh);
            f32x16 O0, O1;
#pragma unroll
            for (int i = 0; i < 16; ++i) { O0[i] = 0.f; O1[i] = 0.f; }
            float m = -INFINITY, l = 0.f;
            const int nA0 = (g == 0) ? 4 : 0, nA = 8 - nA0, nblk = nA + g + 1;
            bf16x8 Kn[4]; u32x4 Vn[4];
            { const int kstart = 128 * g - 128 + 32 * nA0;
              const bf16_t* kp = Z + (size_t)(b * SEQ + kstart + l31) * ZP + 1024 + head * 64 + 8 * hh;
#pragma unroll
              for (int s2 = 0; s2 < 4; ++s2) Kn[s2] = *(const bf16x8*)(kp + 16 * s2);
              const bf16_t* vp = Z + (size_t)(b * SEQ + kstart + vr8) * ZP + 1536 + head * 64 + 8 * vcol;
#pragma unroll
              for (int c4 = 0; c4 < 4; ++c4) Vn[c4] = *(const u32x4*)(vp + (size_t)c4 * 8 * ZP); }
            for (int n = 0; n < nblk; ++n) {
                const bool passA = n < nA;
                const int kstart = passA ? (128 * g - 128 + 32 * (nA0 + n)) : 32 * (n - nA);
                bf16x8 Kc[4];
#pragma unroll
                for (int s2 = 0; s2 < 4; ++s2) Kc[s2] = Kn[s2];
                LAS unsigned char* vb = vbuf + (n & 1) * ATT_VBUF;
#pragma unroll
                for (int c4 = 0; c4 < 4; ++c4) *(LAS u32x4*)(vb + (8 * c4 + vr8) * ATT_RS + vcol * 16) = Vn[c4];
                if (n + 1 < nblk) {
                    const int n1 = n + 1; const bool pA = n1 < nA;
                    const int ks1 = pA ? (128 * g - 128 + 32 * (nA0 + n1)) : 32 * (n1 - nA);
                    const int tk = pA ? (b * SEQ + ks1 + l31) : (b * SEQ + 4 * (ks1 + l31) + r);
                    const int tv = pA ? (b * SEQ + ks1 + vr8) : (b * SEQ + 4 * (ks1 + vr8) + r);
                    const bf16_t* kp = Z + (size_t)tk * ZP + 1024 + head * 64 + 8 * hh;
#pragma unroll
                    for (int s2 = 0; s2 < 4; ++s2) Kn[s2] = *(const bf16x8*)(kp + 16 * s2);
                    const bf16_t* vp = Z + (size_t)tv * ZP + 1536 + head * 64 + 8 * vcol; const size_t vstep = (size_t)(pA ? 8 : 32) * ZP;
#pragma unroll
                    for (int c4 = 0; c4 < 4; ++c4) Vn[c4] = *(const u32x4*)(vp + c4 * vstep);
                }
                f32x16 S;
#pragma unroll
                for (int i = 0; i < 16; ++i) S[i] = 0.f;
#pragma unroll
                for (int s2 = 0; s2 < 4; ++s2) S = __builtin_amdgcn_mfma_f32_32x32x16_bf16(Kc[s2], Qf[s2], S, 0, 0, 0);
                const int qpos = passA ? (128 * g + 4 * l31 + r) : (32 * g + l31);
                const int dbase = qpos - kstart - 4 * hh;
                float bm = -INFINITY; float P[16];
                if (passA) {
#pragma unroll
                    for (int i = 0; i < 16; ++i) { const int d = dbase - ((i & 3) + 8 * (i >> 2));
                        const float sv = ((unsigned)d <= 128u) ? S[i] * SC : -INFINITY; S[i] = sv; bm = fmaxf(bm, sv); }
                } else {
#pragma unroll
                    for (int i = 0; i < 16; ++i) { const int d = dbase - ((i & 3) + 8 * (i >> 2));
                        const bool v1 = (unsigned)d <= 128u, v2 = d >= 0 && (d & 3) == 0;
                        const float sv = (v1 || v2) ? S[i] * SC + ((v1 && v2) ? 1.0f : 0.0f) : -INFINITY; S[i] = sv; bm = fmaxf(bm, sv); }
                }
                bm = fmaxf(bm, __shfl_xor(bm, 32));
                if (__builtin_amdgcn_ballot_w64(bm > m) != 0ull) {
                    const float mnew = fmaxf(m, bm);
                    const float msafe0 = (mnew == -INFINITY) ? 0.f : mnew;
                    const float alpha = __builtin_amdgcn_exp2f(m - msafe0);
                    m = mnew; l *= alpha;
#pragma unroll
                    for (int i = 0; i < 16; ++i) { O0[i] *= alpha; O1[i] *= alpha; }
                }
                const float msafe = (m == -INFINITY) ? 0.f : m;
                float ps = 0.f;
#pragma unroll
                for (int i = 0; i < 16; ++i) { const float p = __builtin_amdgcn_exp2f(S[i] - msafe); P[i] = p; ps += p; }
                l += ps;
                bf16x8 Pf[2];
#pragma unroll
                for (int s2 = 0; s2 < 2; ++s2) {
                    u32x4 pk; pk.x = cvt_pk_bf16(P[8 * s2 + 0], P[8 * s2 + 1]); pk.y = cvt_pk_bf16(P[8 * s2 + 2], P[8 * s2 + 3]);
                    pk.z = cvt_pk_bf16(P[8 * s2 + 4], P[8 * s2 + 5]); pk.w = cvt_pk_bf16(P[8 * s2 + 6], P[8 * s2 + 7]);
                    Pf[s2] = __builtin_bit_cast(bf16x8, pk);
                }
                const unsigned va = (unsigned)(size_t)vb + troff;
                s16x4 v000, v001, v010, v011, v100, v101, v110, v111;
                asm volatile("s_waitcnt lgkmcnt(0)\n\t"
                             "ds_read_b64_tr_b16 %0, %8\n\t"
                             "ds_read_b64_tr_b16 %1, %8 offset:%9\n\t"
                             "ds_read_b64_tr_b16 %2, %8 offset:%10\n\t"
                             "ds_read_b64_tr_b16 %3, %8 offset:%11\n\t"
                             "ds_read_b64_tr_b16 %4, %8 offset:64\n\t"
                             "ds_read_b64_tr_b16 %5, %8 offset:%12\n\t"
                             "ds_read_b64_tr_b16 %6, %8 offset:%13\n\t"
                             "ds_read_b64_tr_b16 %7, %8 offset:%14\n\t"
                             "s_waitcnt lgkmcnt(0)"
                             : "=&v"(v000), "=&v"(v001), "=&v"(v010), "=&v"(v011), "=&v"(v100), "=&v"(v101), "=&v"(v110), "=&v"(v111)
                             : "v"(va), "n"(8 * ATT_RS), "n"(16 * ATT_RS), "n"(24 * ATT_RS), "n"(64 + 8 * ATT_RS), "n"(64 + 16 * ATT_RS), "n"(64 + 24 * ATT_RS)
                             : "memory");
                bf16x8 A00, A01, A10, A11;
                A00 = (bf16x8){v000[0], v000[1], v000[2], v000[3], v001[0], v001[1], v001[2], v001[3]};
                A01 = (bf16x8){v010[0], v010[1], v010[2], v010[3], v011[0], v011[1], v011[2], v011[3]};
                A10 = (bf16x8){v100[0], v100[1], v100[2], v100[3], v101[0], v101[1], v101[2], v101[3]};
                A11 = (bf16x8){v110[0], v110[1], v110[2], v110[3], v111[0], v111[1], v111[2], v111[3]};
                O0 = __builtin_amdgcn_mfma_f32_32x32x16_bf16(A00, Pf[0], O0, 0, 0, 0);
                O0 = __builtin_amdgcn_mfma_f32_32x32x16_bf16(A01, Pf[1], O0, 0, 0, 0);
                O1 = __builtin_amdgcn_mfma_f32_32x32x16_bf16(A10, Pf[0], O1, 0, 0, 0);
                O1 = __builtin_amdgcn_mfma_f32_32x32x16_bf16(A11, Pf[1], O1, 0, 0, 0);
            }
            l += __shfl_xor(l, 32);
            const float inv = 1.0f / l;
            bf16_t* op = YM + (size_t)tq * DM + 512 + head * 64 + 4 * hh;
#pragma unroll
            for (int k4 = 0; k4 < 4; ++k4) {
                u32x2 w0, w1;
                w0.x = cvt_pk_bf16(O0[4 * k4 + 0] * inv, O0[4 * k4 + 1] * inv); w0.y = cvt_pk_bf16(O0[4 * k4 + 2] * inv, O0[4 * k4 + 3] * inv);
                w1.x = cvt_pk_bf16(O1[4 * k4 + 0] * inv, O1[4 * k4 + 1] * inv); w1.y = cvt_pk_bf16(O1[4 * k4 + 2] * inv, O1[4 * k4 + 3] * inv);
                *(u32x2*)(op + 8 * k4) = w0; *(u32x2*)(op + 32 + 8 * k4) = w1;
            }
        }
    }
    __syncthreads();
}
constexpr int SGU_RS = 272;
__device__ __forceinline__ void sgu_mfma(Frame& F, const Args& AR, int li) {
    const bf16_t* Z = (const bf16_t*)(F_WS + WS_Z); bf16_t* YM = (bf16_t*)(F_WS + WS_YM); const float* VS = (const float*)(F_WS + WS_VSTAT);
    const bf16_t* WSB = (const bf16_t*)(F_WS + WS_WSB) + (size_t)li * 8 * 16384;
    const float* GN = KIN(9) + (size_t)li * DM; const float* BS = KIN(11) + (size_t)li * 8 * 128;
    constexpr int IMG = 128 * SGU_RS;
    const int tid = F_TID, lane = tid & 63, wave = __builtin_amdgcn_readfirstlane(tid >> 6);
    const int l31 = lane & 31, hh = lane >> 5, gi2 = (lane >> 4) & 1, q4 = (lane & 15) >> 2, p4 = lane & 3;
    const int ct = wave & 3, ia = wave >> 2;
    const int sj = tid >> 2, sc0 = (tid & 3) * 32;
    u32x4 sp[4]; f32x2 sst[4];
#define SGU_LOAD(unit_) do { const int _bn = (unit_) >> 3, _g = (unit_) & 7, _tok = _bn * 128 + sj; \
        const f32x2* _st = (const f32x2*)(VS + (size_t)_tok * 32) + (tid & 3) * 4; \
        _Pragma("unroll") for (int _i = 0; _i < 4; ++_i) sst[_i] = _st[_i]; \
        const u32x4* _p = (const u32x4*)(Z + (size_t)_tok * ZP + 1024 + _g * 128 + sc0); \
        _Pragma("unroll") for (int _k = 0; _k < 4; ++_k) sp[_k] = _p[_k]; } while (0)
#define SGU_STORE(unit_, buf_) do { const int _g = (unit_) & 7; float sm = 0.f, sq = 0.f; \
        _Pragma("unroll") for (int _i = 0; _i < 4; ++_i) { sm += sst[_i].x; sq += sst[_i].y; } \
        sm += __shfl_xor(sm, 1); sm += __shfl_xor(sm, 2); sq += __shfl_xor(sq, 1); sq += __shfl_xor(sq, 2); \
        const float mean = sm * (1.f / DM), rstd = 1.0f / sqrtf(sq * (1.f / DM) - mean * mean + EPS); \
        const f32x4* gp4 = (const f32x4*)(GN + _g * 128 + sc0); \
        _Pragma("unroll") for (int _k = 0; _k < 4; ++_k) { const u32x4 a = sp[_k]; const f32x4 g0 = gp4[2 * _k], g1 = gp4[2 * _k + 1]; u32x4 w; \
            w.x = cvt_pk_bf16((bf_lo(a.x) - mean) * rstd * g0.x, (bf_hi(a.x) - mean) * rstd * g0.y); w.y = cvt_pk_bf16((bf_lo(a.y) - mean) * rstd * g0.z, (bf_hi(a.y) - mean) * rstd * g0.w); \
            w.z = cvt_pk_bf16((bf_lo(a.z) - mean) * rstd * g1.x, (bf_hi(a.z) - mean) * rstd * g1.y); w.w = cvt_pk_bf16((bf_lo(a.w) - mean) * rstd * g1.z, (bf_hi(a.w) - mean) * rstd * g1.w); \
            *(LAS u32x4*)(F.lds + (buf_) * IMG + sj * SGU_RS + sc0 * 2 + 16 * _k) = w; } } while (0)
    __syncthreads();
    int unit = F_BID, par = 0;
    const bool wlds = (F_G % 8 == 0);
    LAS unsigned char* wtile = F.lds + 2 * IMG;
    if (wlds) { const bf16_t* wsrc = WSB + (size_t)(F_BID & 7) * 16384; u32x4 wv[4];
#pragma unroll
        for (int k = 0; k < 4; ++k) wv[k] = *(const u32x4*)(wsrc + (size_t)((tid >> 4) + 32 * k) * 128 + (tid & 15) * 8);
#pragma unroll
        for (int k = 0; k < 4; ++k) *(LAS u32x4*)(wtile + ((tid >> 4) + 32 * k) * SGU_RS + (tid & 15) * 16) = wv[k]; }
    if (unit < 1024) { SGU_LOAD(unit); SGU_STORE(unit, 0); }
    __syncthreads();
    for (; unit < 1024; unit += F_G, par ^= 1) {
        const int nxt = unit + F_G;
        if (nxt < 1024) SGU_LOAD(nxt);
        const int bn = unit >> 3, g = unit & 7, tok0 = bn * 128;
        LAS unsigned char* vimg = F.lds + par * IMG;
        bf16x8 Bf[2][8]; u32x2 uu[2][4]; float bsv[2];
#pragma unroll
        for (int ib = 0; ib < 2; ++ib) {
            const int it = 2 * ia + ib;
            const int ns = 2 * it + 2;
            const bf16_t* wrow = WSB + (size_t)g * 16384 + (size_t)(32 * it + l31) * 128 + 8 * hh;
#pragma unroll
            for (int s2 = 0; s2 < 8; ++s2) if (s2 < ns) { if (wlds) Bf[ib][s2] = *(const LAS bf16x8*)(wtile + (32 * it + l31) * SGU_RS + (16 * s2 + 8 * hh) * 2); else Bf[ib][s2] = *(const bf16x8*)(wrow + 16 * s2); }
            const int i = 32 * it + l31, tok = tok0 + i; bsv[ib] = BS[g * 128 + i];
            const bf16_t* up = Z + (size_t)tok * ZP + g * 128 + 32 * ct + 4 * hh;
#pragma unroll
            for (int k4 = 0; k4 < 4; ++k4) uu[ib][k4] = *(const u32x2*)(up + 8 * k4);
        }
#pragma unroll
        for (int ib = 0; ib < 2; ++ib) {
            const int it = 2 * ia + ib, ns = 2 * it + 2;
            const int i = 32 * it + l31, tok = tok0 + i;
            bf16_t* op = YM + (size_t)tok * DM + g * 128 + 32 * ct + 4 * hh;
            f32x16 C;
#pragma unroll
            for (int q = 0; q < 16; ++q) C[q] = 0.f;
            const unsigned va = (unsigned)(size_t)vimg + (unsigned)((8 * hh + q4) * SGU_RS + (32 * ct + 16 * gi2 + 4 * p4) * 2);
#pragma unroll
            for (int s4 = 0; s4 < 4; ++s4) {
                if (2 * s4 < ns) {
                    s16x4 t0, t1, t2, t3;
                    asm volatile("ds_read_b64_tr_b16 %0, %4\n\tds_read_b64_tr_b16 %1, %4 offset:%5\n\tds_read_b64_tr_b16 %2, %4 offset:%6\n\tds_read_b64_tr_b16 %3, %4 offset:%7\n\ts_waitcnt lgkmcnt(0)"
                                 : "=&v"(t0), "=&v"(t1), "=&v"(t2), "=&v"(t3) : "v"(va + (unsigned)(32 * s4 * SGU_RS)), "n"(4 * SGU_RS), "n"(16 * SGU_RS), "n"(20 * SGU_RS) : "memory");
                    const bf16x8 A0 = (bf16x8){t0[0], t0[1], t0[2], t0[3], t1[0], t1[1], t1[2], t1[3]};
                    const bf16x8 A1 = (bf16x8){t2[0], t2[1], t2[2], t2[3], t3[0], t3[1], t3[2], t3[3]};
                    C = __builtin_amdgcn_mfma_f32_32x32x16_bf16(A0, Bf[ib][2 * s4], C, 0, 0, 0);
                    C = __builtin_amdgcn_mfma_f32_32x32x16_bf16(A1, Bf[ib][2 * s4 + 1], C, 0, 0, 0);
                }
            }
            const float bv = bsv[ib];
#pragma unroll
            for (int k4 = 0; k4 < 4; ++k4) { u32x2 w;
                w.x = cvt_pk_bf16(bf_lo(uu[ib][k4].x) * (C[4 * k4 + 0] + bv), bf_hi(uu[ib][k4].x) * (C[4 * k4 + 1] + bv)); w.y = cvt_pk_bf16(bf_lo(uu[ib][k4].y) * (C[4 * k4 + 2] + bv), bf_hi(uu[ib][k4].y) * (C[4 * k4 + 3] + bv));
                *(u32x2*)(op + 8 * k4) = w; }
        }
        if (nxt < 1024) SGU_STORE(nxt, par ^ 1);
        __syncthreads();
    }
#undef SGU_LOAD
#undef SGU_STORE
}
template <int W>
__device__ __forceinline__ void pool_window(const bf16_t* zp, int t, bf16x8 (&Bf)[8]) {
    const int cntw = (t + 1) < W ? (t + 1) : W; const float inv = 1.0f / (float)cntw;
#pragma unroll
    for (int s2 = 0; s2 < 8; ++s2) {
        u32x4 a[W];
#pragma unroll
        for (int j = 0; j < W; ++j) { const int jj = j < cntw ? j : 0; a[j] = *(const u32x4*)(zp - (size_t)jj * ZP + 16 * s2); }
        float acc[8];
#pragma unroll
        for (int i = 0; i < 8; ++i) acc[i] = 0.f;
#pragma unroll
        for (int j = 0; j < W; ++j) { const float m = j < cntw ? 1.f : 0.f;
            acc[0] += m * bf_lo(a[j].x); acc[1] += m * bf_hi(a[j].x); acc[2] += m * bf_lo(a[j].y); acc[3] += m * bf_hi(a[j].y);
            acc[4] += m * bf_lo(a[j].z); acc[5] += m * bf_hi(a[j].z); acc[6] += m * bf_lo(a[j].w); acc[7] += m * bf_hi(a[j].w); }
        const float s0 = bf_lo(a[0].x), s1 = bf_hi(a[0].x), s2f = bf_lo(a[0].y), s3 = bf_hi(a[0].y), s4 = bf_lo(a[0].z), s5 = bf_hi(a[0].z), s6 = bf_lo(a[0].w), s7 = bf_hi(a[0].w);
        u32x4 pk; pk.x = cvt_pk_bf16(acc[0] * inv - s0, acc[1] * inv - s1); pk.y = cvt_pk_bf16(acc[2] * inv - s2f, acc[3] * inv - s3);
        pk.z = cvt_pk_bf16(acc[4] * inv - s4, acc[5] * inv - s5); pk.w = cvt_pk_bf16(acc[6] * inv - s6, acc[7] * inv - s7);
        Bf[s2] = __builtin_bit_cast(bf16x8, pk);
    }
}
constexpr int POOL_RS = 272;
constexpr int POOL_TILE = 48 * POOL_RS;
template <int W>
__device__ __forceinline__ void pool_window_lds(const bf16_t* Zg, int tok0, int lane, LAS unsigned char* tile, bf16x8 (&Bf)[8]) {
    constexpr int NR = 32 + W - 1, NI = (NR + 3) / 4;
    const int rr = lane >> 4, cc = lane & 15;
    u32x4 st[NI];
#pragma unroll
    for (int i = 0; i < NI; ++i) { const int r = 4 * i + rr; int tk = tok0 - (W - 1) + r; tk = tk < 0 ? 0 : tk; tk = tk > NT - 1 ? NT - 1 : tk;
        st[i] = *(const u32x4*)(Zg + (size_t)tk * ZP + cc * 8); }
#pragma unroll
    for (int i = 0; i < NI; ++i) { const int r = 4 * i + rr; if (r < NR) *(LAS u32x4*)(tile + r * POOL_RS + cc * 16) = st[i]; }
    LDS_WAIT(); asm volatile("" ::: "memory");
    const int l31 = lane & 31, hh = lane >> 5, t = (tok0 + l31) % SEQ;
    const int cntw = (t + 1) < W ? (t + 1) : W; const float inv = 1.0f / (float)cntw;
    const LAS unsigned char* base = tile + (l31 + W - 1) * POOL_RS + hh * 16;
#pragma unroll
    for (int s2 = 0; s2 < 8; ++s2) {
        u32x4 a[W];
#pragma unroll
        for (int j = 0; j < W; ++j) a[j] = *(const LAS u32x4*)(base - j * POOL_RS + 32 * s2);
        float acc[8];
#pragma unroll
        for (int i = 0; i < 8; ++i) acc[i] = 0.f;
#pragma unroll
        for (int j = 0; j < W; ++j) { const float m = j < cntw ? 1.f : 0.f;
            acc[0] += m * bf_lo(a[j].x); acc[1] += m * bf_hi(a[j].x); acc[2] += m * bf_lo(a[j].y); acc[3] += m * bf_hi(a[j].y);
            acc[4] += m * bf_lo(a[j].z); acc[5] += m * bf_hi(a[j].z); acc[6] += m * bf_lo(a[j].w); acc[7] += m * bf_hi(a[j].w); }
        const float s0 = bf_lo(a[0].x), s1 = bf_hi(a[0].x), s2f = bf_lo(a[0].y), s3 = bf_hi(a[0].y), s4 = bf_lo(a[0].z), s5 = bf_hi(a[0].z), s6 = bf_lo(a[0].w), s7 = bf_hi(a[0].w);
        u32x4 pk; pk.x = cvt_pk_bf16(acc[0] * inv - s0, acc[1] * inv - s1); pk.y = cvt_pk_bf16(acc[2] * inv - s2f, acc[3] * inv - s3);
        pk.z = cvt_pk_bf16(acc[4] * inv - s4, acc[5] * inv - s5); pk.w = cvt_pk_bf16(acc[6] * inv - s6, acc[7] * inv - s7);
        Bf[s2] = __builtin_bit_cast(bf16x8, pk);
    }
}
__device__ __forceinline__ void pool_mfma(Frame& F, const Args& AR, int li) {
    const bf16_t* Z = (const bf16_t*)(F_WS + WS_Z); bf16_t* YM = (bf16_t*)(F_WS + WS_YM);
    const bf16_t* PWT = (const bf16_t*)(F_WS + WS_PWT) + (size_t)li * 4 * 16384; const float* PS = KIN(7) + (size_t)li * 512;
    const int lane = F_LANE, l31 = lane & 31, hh = lane >> 5;
    const int NJOB = 2048, W0 = F_BID * NWAVES + F_WAVE, NW = F_G * NWAVES;
    for (int job = W0; job < NJOB; job += NW) {
        const int g = job & 3, tile = job >> 2;
        const int tok = tile * 32 + l31, t = tok % SEQ;
        bf16x8 Bf[8];
        const bf16_t* Zg = Z + g * 128; LAS unsigned char* ptile = F.lds + F_WAVE * POOL_TILE;
        switch (__builtin_amdgcn_readfirstlane(g)) {
            case 0: pool_window_lds<2>(Zg, tile * 32, lane, ptile, Bf); break;
            case 1: pool_window_lds<4>(Zg, tile * 32, lane, ptile, Bf); break;
            case 2: pool_window_lds<8>(Zg, tile * 32, lane, ptile, Bf); break;
            default: pool_window_lds<16>(Zg, tile * 32, lane, ptile, Bf); break;
        }
#pragma unroll
        for (int dt = 0; dt < 4; ++dt) {
            f32x16 C;
#pragma unroll
            for (int i = 0; i < 16; ++i) C[i] = 0.f;
            const bf16_t* arow = PWT + (size_t)g * 16384 + (size_t)(32 * dt + l31) * 128 + 8 * hh;
#pragma unroll
            for (int s2 = 0; s2 < 8; ++s2) { const bf16x8 Af = *(const bf16x8*)(arow + 16 * s2); C = __builtin_amdgcn_mfma_f32_32x32x16_bf16(Af, Bf[s2], C, 0, 0, 0); }
            bf16_t* op = YM + (size_t)tok * DM + g * 128 + 32 * dt + 4 * hh; const float* ps = PS + g * 128 + 32 * dt + 4 * hh;
#pragma unroll
            for (int k4 = 0; k4 < 4; ++k4) { const f32x4 sc = *(const f32x4*)(ps + 8 * k4); u32x2 wv;
                wv.x = cvt_pk_bf16(C[4 * k4 + 0] * sc.x, C[4 * k4 + 1] * sc.y); wv.y = cvt_pk_bf16(C[4 * k4 + 2] * sc.z, C[4 * k4 + 3] * sc.w);
                *(u32x2*)(op + 8 * k4) = wv; }
        }
    }
}
typedef float f32x4v __attribute__((ext_vector_type(4)));
__device__ __forceinline__ void router_mfma(Frame& F, const Args& AR, int layer) {
    const bf16_t* WRH = (const bf16_t*)(F_WS + WS_WRT) + (size_t)layer * 80 * 1024; const bf16_t* WRL = WRH + NL * 80 * 1024; const bf16_t* XBp = (const bf16_t*)(F_WS + WS_XB);
    const float* GB = KIN(14) + layer * 8; const float* EB = KIN(16) + layer * 64; const float* gn = KIN(2) + (size_t)layer * DM;
    i32x4* list = (i32x4*)(F_WS + WS_LIST); i32x4* tinfo = (i32x4*)(F_WS + WS_TOKINFO);
    unsigned* cnt = F_CTL + CW_CNT + layer * NE * 64;
    LAS float* part = (LAS float*)(F.lds);
    LAS float* lg = (LAS float*)(F.lds + 90112);
    LAS float* rs = (LAS float*)(F.lds + 90112 + 20992);
    LAS unsigned* lcnt = (LAS unsigned*)(F.lds + 90112 + 20992 + 256);
    const int lane = F_LANE, a_tok = lane & 15, kq = lane >> 4, w = F_WAVE;
    for (int unit = F_BID; unit < NT / 64; unit += F_G) {
        const int tokb = unit * 64;
        f32x4 acc[4][5]; float ss[4];
#pragma unroll
        for (int t = 0; t < 4; ++t) { ss[t] = 0.f;
#pragma unroll
            for (int nt = 0; nt < 5; ++nt) acc[t][nt] = (f32x4){0.f, 0.f, 0.f, 0.f}; }
        const unsigned woff = (unsigned)((a_tok * 1024 + w * 128 + 8 * kq) * 2), xoff = (unsigned)(((tokb + a_tok) * DM + w * 128 + 8 * kq) * 2);
        const GAS char* whb[5]; const GAS char* wlb[5]; const GAS char* xb = (const GAS char*)XBp;
#pragma unroll
        for (int nt = 0; nt < 5; ++nt) { whb[nt] = (const GAS char*)WRH + nt * 32768; wlb[nt] = (const GAS char*)WRL + nt * 32768; asm volatile("" : "+s"(whb[nt]), "+s"(wlb[nt])); }
        bf16x8 wh[2][5], wl[2][5]; u32x4 xv[2][4];
#define R_LOAD(b, j) { _Pragma("unroll") for (int nt = 0; nt < 5; ++nt) { wh[b][nt] = *(const GAS bf16x8*)(whb[nt] + 64 * (j) + woff); wl[b][nt] = *(const GAS bf16x8*)(wlb[nt] + 64 * (j) + woff); } \
                       _Pragma("unroll") for (int t = 0; t < 4; ++t) xv[b][t] = *(const GAS u32x4*)(xb + (t * 16 * DM * 2 + 64 * (j)) + xoff); }
#define R_COMP(b) { _Pragma("unroll") for (int t = 0; t < 4; ++t) { const u32x4 xr4 = xv[b][t]; \
                { const float x0 = bf_lo(xr4.x), x1 = bf_hi(xr4.x), x2 = bf_lo(xr4.y), x3 = bf_hi(xr4.y), x4 = bf_lo(xr4.z), x5 = bf_hi(xr4.z), x6 = bf_lo(xr4.w), x7 = bf_hi(xr4.w); \
                  ss[t] += ((x0 * x0 + x1 * x1) + (x2 * x2 + x3 * x3)) + ((x4 * x4 + x5 * x5) + (x6 * x6 + x7 * x7)); } \
                const bf16x8 xa = __builtin_bit_cast(bf16x8, xr4); \
                _Pragma("unroll") for (int nt = 0; nt < 5; ++nt) { acc[t][nt] = __builtin_amdgcn_mfma_f32_16x16x32_bf16(xa, wh[b][nt], acc[t][nt], 0, 0, 0); acc[t][nt] = __builtin_amdgcn_mfma_f32_16x16x32_bf16(xa, wl[b][nt], acc[t][nt], 0, 0, 0); } } }
        R_LOAD(0, 0); R_LOAD(1, 1); __builtin_amdgcn_sched_barrier(0);
        R_COMP(0); __builtin_amdgcn_sched_barrier(0); R_LOAD(0, 2); __builtin_amdgcn_sched_barrier(0);
        R_COMP(1); __builtin_amdgcn_sched_barrier(0); R_LOAD(1, 3); __builtin_amdgcn_sched_barrier(0);
        R_COMP(0); R_COMP(1);
#undef R_LOAD
#undef R_COMP
#pragma unroll
        for (int t = 0; t < 4; ++t) { ss[t] += __shfl_xor(ss[t], 16); ss[t] += __shfl_xor(ss[t], 32); }
#pragma unroll
        for (int half = 4; half >= 1; half >>= 1) {
            __syncthreads();
            if (w >= half && w < 2 * half) { LAS f32x4* p = (LAS f32x4*)part + (size_t)(w - half) * (21 * 64) + lane;
#pragma unroll
                for (int t = 0; t < 4; ++t) {
#pragma unroll
                    for (int nt = 0; nt < 5; ++nt) p[(t * 5 + nt) * 64] = acc[t][nt]; }
                p[20 * 64] = (f32x4){ss[0], ss[1], ss[2], ss[3]}; }
            __syncthreads();
            if (w < half) { const LAS f32x4* p = (const LAS f32x4*)part + (size_t)w * (21 * 64) + lane;
#pragma unroll
                for (int t = 0; t < 4; ++t) {
#pragma unroll
                    for (int nt = 0; nt < 5; ++nt) acc[t][nt] += p[(t * 5 + nt) * 64]; }
                const f32x4 s4 = p[20 * 64]; ss[0] += s4.x; ss[1] += s4.y; ss[2] += s4.z; ss[3] += s4.w; }
        }
        if (w == 0) {
            const int l2 = F_LANE, a2 = l2 & 15, k2 = l2 >> 4;
#pragma unroll
            for (int t = 0; t < 4; ++t) { const float rstd = 1.0f / sqrtf(ss[t] * (1.f / DM) + EPS); if (k2 == 0) rs[t * 16 + a2] = rstd; }
            LDS_WAIT(); asm volatile("" ::: "memory");
            LAS float* lgb = lg + k2 * 324 + a2; const LAS float* rsb = rs + 4 * k2;
#pragma unroll
            for (int nt = 0; nt < 5; ++nt) { const int n = 16 * nt + a2; const float bias = n < 8 ? GB[n] : (n < 72 ? EB[n - 8] : 0.f);
#pragma unroll
                for (int t = 0; t < 4; ++t) {
#pragma unroll
                    for (int rg = 0; rg < 4; ++rg) lgb[(t * 16 + rg) * 81 + 16 * nt] = acc[t][nt][rg] * rsb[t * 16 + rg] + bias; } }
        }
        __syncthreads();
        int x1 = 0, x2 = 0; unsigned r1 = 0, r2 = 0; float g1 = 0.f, g2 = 0.f;
        if (F_TID < 64) lcnt[F_TID] = 0u;
        __syncthreads();
        if (F_TID < 64) {
            const LAS float* L = lg + F_TID * 81;
            float m = L[0]; int gi = 0;
            for (int i = 1; i < 8; ++i) if (L[i] > m) { m = L[i]; gi = i; }
            float s = 0.f; for (int i = 0; i < 8; ++i) s += __expf(L[i] - m);
            const float gp = 1.0f / s;
            const LAS float* E = L + 8 + gi * 8;
            float t1 = E[0]; int i1 = 0;
            for (int i = 1; i < 8; ++i) if (E[i] > t1) { t1 = E[i]; i1 = i; }
            float t2 = -INFINITY; int i2 = 0;
            for (int i = 0; i < 8; ++i) if (i != i1 && E[i] > t2) { t2 = E[i]; i2 = i; }
            const float e2 = __expf(t2 - t1); const float p1 = 1.0f / (1.0f + e2), p2 = e2 / (1.0f + e2);
            x1 = gi * 8 + i1; x2 = gi * 8 + i2; g1 = gp * p1; g2 = gp * p2;
            r1 = __hip_atomic_fetch_add(lcnt + x1, 1u, __ATOMIC_RELAXED, __HIP_MEMORY_SCOPE_WORKGROUP);
            r2 = __hip_atomic_fetch_add(lcnt + x2, 1u, __ATOMIC_RELAXED, __HIP_MEMORY_SCOPE_WORKGROUP);
        }
        __syncthreads();
        if (F_TID < 64) { const unsigned c = lcnt[F_TID]; unsigned base = 0u;
            if (c) base = __hip_atomic_fetch_add(cnt + F_TID * 64, c, __ATOMIC_RELAXED, __HIP_MEMORY_SCOPE_AGENT);
            lcnt[F_TID] = base; }
        __syncthreads();
        if (F_TID < 64) {
            const int tok = tokb + F_TID; const int pos1 = (int)(lcnt[x1] + r1), pos2 = (int)(lcnt[x2] + r2);
            const int rsi = __float_as_int(rs[F_TID]);
            list[(size_t)x1 * NT + pos1] = (i32x4){tok, __float_as_int(g1), rsi, 0};
            list[(size_t)x2 * NT + pos2] = (i32x4){tok, __float_as_int(g2), rsi, 0};
            tinfo[tok] = (i32x4){x1, pos1, x2, pos2};
        }
    }
    __syncthreads();
}
__device__ __forceinline__ void combine_phase(Frame& F, const Args& AR, int layer, bool have_seg) {
    const MoeTabs T = moe_tabs(F);
    if (!have_seg) moe_build_seg(F, AR, T, layer);
    const bf16_t* Y = (const bf16_t*)(F_WS + WS_YMOE); const i32x4* tinfo = (const i32x4*)(F_WS + WS_TOKINFO);
    const bool lastl = (layer == NL - 1);
    const float* gn = lastl ? KIN(3) : KIN(1) + (size_t)(layer + 1) * DM;
    const int gw = F_BID * NWAVES + F_WAVE, NGW = F_G * NWAVES;
    for (int m0 = gw; m0 < NT; m0 += 2 * NGW) {
        const int m1 = m0 + NGW; const bool two = m1 < NT;
        const i32x4 ti0 = tinfo[m0]; i32x4 ti1 = ti0; if (two) ti1 = tinfo[m1];
        u32x2 ya[2][4], yb[2][4], xv[2][4];
#pragma unroll
        for (int q = 0; q < 2; ++q) {
            const i32x4 ti = q ? ti1 : ti0; const int m = q ? (two ? m1 : m0) : m0;
            const int ra = T.seg[ti.x] + ti.y, rb = T.seg[ti.z] + ti.w;
            const u32x2* xi = (const u32x2*)((const bf16_t*)(F_WS + WS_XB) + (size_t)m * DM) + F_LANE; const u32x2* pa = (const u32x2*)(Y + (size_t)ra * DM) + F_LANE; const u32x2* pb = (const u32x2*)(Y + (size_t)rb * DM) + F_LANE;
#pragma unroll
            for (int j = 0; j < 4; ++j) { ya[q][j] = pa[64 * j]; yb[q][j] = pb[64 * j]; xv[q][j] = xi[64 * j]; }
        }
#pragma unroll
        for (int q = 0; q < 2; ++q) {
            if (q == 1 && !two) break;
            const int m = q ? m1 : m0;
            u32x2* xr = (u32x2*)((bf16_t*)(F_WS + WS_X16) + (size_t)m * DM) + F_LANE;
            f32x4 v[4];
#pragma unroll
            for (int j = 0; j < 4; ++j) { const u32x2 a = ya[q][j], b = yb[q][j]; const u32x2 xx = xv[q][j]; f32x4 x = (f32x4){bf_lo(xx.x), bf_hi(xx.x), bf_lo(xx.y), bf_hi(xx.y)};
#ifndef DBG_NO_MOE
                x.x += bf_lo(a.x) + bf_lo(b.x); x.y += bf_hi(a.x) + bf_hi(b.x); x.z += bf_lo(a.y) + bf_lo(b.y); x.w += bf_hi(a.y) + bf_hi(b.y);
#endif
                v[j] = x; }
            if (lastl) norm_row(v, gn, F_LANE, nullptr, F_X + (size_t)m * DM);
            else {
#pragma unroll
                for (int j = 0; j < 4; ++j) { u32x2 w; w.x = cvt_pk_bf16(v[j].x, v[j].y); w.y = cvt_pk_bf16(v[j].z, v[j].w); xr[64 * j] = w; }
                row_rstd(v, F_LANE, (float*)(F_WS + WS_RSTD) + m);
            }
        }
    }
}

constexpr int NPH = 1 + NL * 7;
#ifndef PH_MASK
#define PH_MASK 0xFF
#endif
#define EN(b) (((PH_MASK) >> (b)) & 1)
#ifndef REP_MASK
#define REP_MASK 0
#endif
#define REPS(b) (1 + (((REP_MASK) >> (b)) & 1))
#define IN(k) (AR.ph_lo <= (k) && (k) < AR.ph_hi)
#define SEAM(k) do { if (IN((k) + 1)) { XcdBarrier _b; _b.bar = F_CTL + CW_BAR; _b.x = xb_xcc_id(); _b.st = (volatile LAS unsigned*)(F.lds + MISC_OFF + MO_BAR); xcd_barrier(_b); } } while (0)

template <int layer>
__device__ __forceinline__ void layer_phases(Frame& F, const Args& AR) {
    constexpr int pb = 1 + layer * 7; constexpr int li = layer >> 1; constexpr bool odd = (layer & 1) != 0;
    if (EN(0) && IN(pb + 0)) {
        pg8::PlainSched S; S.init(F_WS + WS_X16, F_WS + WS_WIN + (size_t)layer * 2048 * DM * 2, NT, 2048, DM, F_G, F_BID);
        pg8::EpiZ<odd> E{(bf16_t*)(F_WS + WS_Z), (float*)(F_WS + WS_VSTAT), (const float*)(F_WS + WS_RSTD)}; for (int rep = 0; rep < REPS(0); ++rep) pg8::gemm_phase<pg8::EpiZ<odd>, pg8::PlainSched, true>(F.lds, DM, S, E);
        SEAM(pb + 0);
    }
    if (EN(1) && IN(pb + 1)) {
        for (int rep = 0; rep < REPS(1); ++rep) { if (!odd) { for (int r2 = 0; r2 < REPS(8); ++r2) attn_mfma(F, AR); for (int r2 = 0; r2 < REPS(9); ++r2) pool_mfma(F, AR, li); } else { for (int r2 = 0; r2 < REPS(10); ++r2) sgu_mfma(F, AR, li); } }
        SEAM(pb + 1);
    }
    if (EN(2) && IN(pb + 2)) {
        pg8::PlainSched S; S.init(F_WS + WS_YM, F_WS + WS_WOUT + (size_t)layer * DM * DM * 2, NT, DM, DM, F_G, F_BID);
        pg8::EpiResid E{(const bf16_t*)(F_WS + WS_X16), (bf16_t*)(F_WS + WS_XB)}; for (int rep = 0; rep < REPS(2); ++rep) pg8::gemm_phase<pg8::EpiResid, pg8::PlainSched, false>(F.lds, DM, S, E);
        SEAM(pb + 2);
    }
    if (EN(3) && IN(pb + 3)) { router_mfma(F, AR, layer); SEAM(pb + 3); }
    if (EN(4) && IN(pb + 4)) {
        const MoeTabs T = moe_tabs(F);
        moe_build_seg(F, AR, T, layer);
        const int nfull = __builtin_amdgcn_readfirstlane(T.fst[NE]), total = nfull + __builtin_amdgcn_readfirstlane(T.hst[NE]);
        const bool fusedM = EN(5) && IN(pb + 5) && moe_fusable(nfull, total, F_G);
        for (int rep = 0; rep < REPS(4); ++rep)
        for (int base = 0; base < total; base += MAXU * F_G) {
            int nfw; const int nu = moe_build_units(F, AR, T, layer, base, true, nfull, total, false, nfw);
            pg4::gemm4_phase<0, 32, DE>(F.lds, T.tab, T.toks, T.rstd, (const char*)(F_WS + WS_XB), KIN(17), KIN(18), KIN(2) + (size_t)layer * DM, (bf16_t*)(F_WS + WS_HMOE), layer, nu);
            __syncthreads();
            if (fusedM && rep == 0) moe_publish(F, AR, T, layer, nu);
        }
        if (!fusedM) SEAM(pb + 4);
    }
    if (EN(5) && IN(pb + 5)) {
        const MoeTabs T = moe_tabs(F);
        const bool have = EN(4) && IN(pb + 4);
        if (!have) moe_build_seg(F, AR, T, layer);
        const int nfull = __builtin_amdgcn_readfirstlane(T.fst[NE]), total = nfull + __builtin_amdgcn_readfirstlane(T.hst[NE]);
        const bool fusedM = have && moe_fusable(nfull, total, F_G);
        const bool reuse = have && !fusedM && total <= MAXU * F_G;
        for (int rep = 0; rep < REPS(5); ++rep)
        for (int base = 0; base < total; base += MAXU * F_G) {
            int nfw; const int nu = moe_build_units(F, AR, T, layer, base, !reuse && !fusedM, nfull, total, fusedM, nfw);
            if (!fusedM) nfw = nu;
#pragma nounroll
            for (int part = 0; part < 2; ++part) { const int s0 = part ? nfw : 0, s1 = part ? nu : nfw;
                if (s1 > s0) {
                    if (fusedM && part) { int dummy; (void)moe_build_units(F, AR, T, layer, base, true, nfull, total, true, dummy, nfw); }
                    if (fusedM) moe_wait(F, AR, T, layer, s0, s1);
                    pg4::gemm4_phase<1, 16, DM>(F.lds, T.tab + s0 * 8, T.toks + s0 * 256, T.gates + s0 * 256, (const char*)(F_WS + WS_HMOE), KIN(19), KIN(19), nullptr, (bf16_t*)(F_WS + WS_YMOE), layer, s1 - s0);
                    __syncthreads(); } }
        }
        SEAM(pb + 5);
    }
        if (EN(6) && IN(pb + 6)) { for (int rep = 0; rep < REPS(6); ++rep) combine_phase(F, AR, layer, (EN(4) && IN(pb + 4)) || (EN(5) && IN(pb + 5)));
    if (layer + 1 < NL) SEAM(pb + 6); }
}

__global__ void __launch_bounds__(NTHR, 2) fwd_kernel(Args AR) {
    extern __shared__ __attribute__((aligned(16))) unsigned char lds_raw[];
    Frame F;
    F.lds = (LAS unsigned char*)lds_raw;
    for (int u = F_TID; u < (LDS_BYTES - MISC_OFF) / 4; u += NTHR) ((LAS unsigned*)(F.lds + MISC_OFF))[u] = 0u;
    __syncthreads();
    if (AR.ph_hi - AR.ph_lo > 1) (void)xcd_barrier_post(F_CTL + CW_BAR, (volatile LAS unsigned*)(F.lds + MISC_OFF + MO_BAR));

    if (EN(7) && IN(0)) { for (int rep = 0; rep < REPS(7); ++rep) p0_prologue(F, AR); SEAM(0); }
    layer_phases<0>(F, AR);
    layer_phases<1>(F, AR);
    layer_phases<2>(F, AR);
    layer_phases<3>(F, AR);
}
#undef IN
#undef SEAM

extern "C" void kernel_launch(void* const* d_in, const int* in_sizes, int n_in, void* d_out, int out_size, void* d_ws, size_t ws_size, hipStream_t stream) {
    static int grid = 0;
    if (grid == 0) {
        if (n_in != 20 || out_size != NT * DM || ws_size < WS_END) { fprintf(stderr, "kernel_launch: unexpected problem (n_in %d out %d ws %zu)\n", n_in, out_size, ws_size); grid = -1; return; }
        int dev = 0, cus = 0, per_cu = 0;
        if (hipGetDevice(&dev) != hipSuccess || hipDeviceGetAttribute(&cus, hipDeviceAttributeMultiprocessorCount, dev) != hipSuccess) { grid = -1; return; }
        if (hipFuncSetAttribute((const void*)fwd_kernel, hipFuncAttributeMaxDynamicSharedMemorySize, LDS_BYTES) != hipSuccess) { fprintf(stderr, "kernel_launch: hipFuncSetAttribute failed\n"); grid = -1; return; }
        if (hipOccupancyMaxActiveBlocksPerMultiprocessor(&per_cu, (const void*)fwd_kernel, NTHR, LDS_BYTES) != hipSuccess || per_cu < 1) fprintf(stderr, "kernel_launch: occupancy query says %d\n", per_cu);
        (void)hipGetLastError();
        grid = cus;
    }
    if (grid < 0) return;
    (void)hipMemsetAsync((char*)d_ws + WS_CTL, 0, CTL_ZERO_BYTES, stream);
    Args a{};
    for (int i = 0; i < 20; ++i) a.in[i] = (const float*)d_in[i];
    a.out = (float*)d_out; a.ws = (unsigned char*)d_ws;
#if MK_ONE_LAUNCH
    a.ph_lo = 0; a.ph_hi = NPH;
    hipLaunchKernelGGL(fwd_kernel, dim3(grid), dim3(NTHR), LDS_BYTES, stream, a);
#else
    for (int p = 0; p < NPH; ++p) { a.ph_lo = p; a.ph_hi = p + 1; hipLaunchKernelGGL(fwd_kernel, dim3(grid), dim3(NTHR), LDS_BYTES, stream, a); }
#endif
}
```
